# Optimizing an MI355X kernel written in HIP

```python
import math
import jax, jax.numpy as jnp
from jax import lax
import numpy as np

D_MODEL = 1024
BATCH = 8
SEQ = 2048
DEPTH = 4

HEAD_DIM = 64
SB_HEADS = 8
SB_WIDTH = SB_HEADS * HEAD_DIM
NSA_HEADS = 8
NSA_KV_HEADS = 2
NSA_GROUP = NSA_HEADS // NSA_KV_HEADS
NSA_WIDTH = NSA_HEADS * HEAD_DIM
NSA_KV_WIDTH = NSA_KV_HEADS * HEAD_DIM
CMP_LEN = 32
CMP_STRIDE = 16
CMP_HIDDEN = 128
SLC_BLOCK = 64
SLC_TOPK = 8
WINDOW = 256
Q_BLOCK = 128
ROPE_THETA = 10000.0
EPS = 1e-6
NEG = -1e30
FORCE = 1e4
IN_SIZES = (SB_WIDTH, SB_WIDTH, SB_WIDTH, SB_WIDTH,
            NSA_WIDTH, NSA_KV_WIDTH, NSA_KV_WIDTH, NSA_KV_WIDTH, NSA_KV_WIDTH, NSA_KV_WIDTH, NSA_KV_WIDTH,
            NSA_WIDTH, 3 * NSA_HEADS, D_MODEL, D_MODEL)
N_IN = sum(IN_SIZES)

kernel_name = "hybrid_stickbreaking_nsa_adaln"


def rms_norm(x, g):
    xf = x.astype(jnp.float32)
    y = xf * lax.rsqrt(jnp.mean(xf * xf, axis=-1, keepdims=True) + EPS)
    return (y * g.astype(jnp.float32)).astype(x.dtype)


def rope(x, pos):
    half = x.shape[-1] // 2
    freq = ROPE_THETA ** (-jnp.arange(half, dtype=jnp.float32) / half)
    ang = pos.astype(jnp.float32)[:, None] * freq[None, :]
    cos = jnp.cos(ang)[None, :, None, :]
    sin = jnp.sin(ang)[None, :, None, :]
    xf = x.astype(jnp.float32)
    x1, x2 = xf[..., :half], xf[..., half:]
    return jnp.concatenate([x1 * cos - x2 * sin, x2 * cos + x1 * sin], axis=-1).astype(x.dtype)


def stick_breaking_attention(q, k, v):
    B, S, H, d = q.shape
    scale = d ** -0.5
    qh, kh, vh = (a.transpose(0, 2, 1, 3) for a in (q, k, v))
    outs = []
    for i in range(S // Q_BLOCK):
        t0, t1 = i * Q_BLOCK, (i + 1) * Q_BLOCK
        z = jnp.einsum('bhqd,bhkd->bhqk', qh[:, :, t0:t1], kh[:, :, :t1]).astype(jnp.float32) * scale
        strict = jnp.arange(t1)[None, :] < jnp.arange(t0, t1)[:, None]
        log_keep = jnp.where(strict, jax.nn.log_sigmoid(-z), 0.0)
        between = lax.cumsum(log_keep, axis=3, reverse=True) - log_keep
        w = jnp.where(strict, jnp.exp(jax.nn.log_sigmoid(z) + between), 0.0)
        outs.append(jnp.einsum('bhqk,bhkd->bqhd', w.astype(v.dtype), vh[:, :, :t1]))
    return jnp.concatenate(outs, axis=1)


def compress(x, pe, w1, w2):
    B, S, G, d = x.shape
    n = (S - CMP_LEN) // CMP_STRIDE + 1
    idx = CMP_STRIDE * jnp.arange(n)[:, None] + jnp.arange(CMP_LEN)[None, :]
    blocks = x[:, idx] + pe[None, None, :, None, :]
    flat = blocks.transpose(0, 1, 3, 2, 4).reshape(B, n, G, CMP_LEN * d)
    hid = jax.nn.silu(jnp.einsum('bngf,fh->bngh', flat, w1))
    return jnp.einsum('bngh,hd->bngd', hid, w2)


def band_blocks(x, n_q, n_band):
    B, S, G, d = x.shape
    xp = jnp.pad(x.transpose(0, 2, 1, 3), ((0, 0), (0, 0), (WINDOW, 0), (0, 0)))
    xb = xp.reshape(B, G, n_q + n_band - 1, Q_BLOCK, d)
    return jnp.concatenate([xb[:, :, o:o + n_q] for o in range(n_band)], axis=3)


def native_sparse_attention(q, kc, vc, ks, vs, kw, vw, gate_logits):
    B, S, H, d = q.shape
    G = NSA_KV_HEADS
    hpg = NSA_GROUP
    scale = d ** -0.5
    dt = q.dtype
    qg = q.reshape(B, S, G, hpg, d)
    t_all = jnp.arange(S)

    n = kc.shape[1]
    ends = CMP_STRIDE * jnp.arange(n) + CMP_LEN - 1
    valid = ends[None, :] <= t_all[:, None]
    s_c = jnp.einsum('bsghd,bngd->bghsn', qg, kc).astype(jnp.float32) * scale
    p_c = jnp.where(valid, jax.nn.softmax(jnp.where(valid, s_c, NEG), axis=-1), 0.0)
    o_cmp = jnp.einsum('bghsn,bngd->bsghd', p_c.astype(dt), vc)

    nb = S // SLC_BLOCK
    ci = jnp.arange(n)[:, None]
    sj = jnp.arange(nb)[None, :]
    overlap = ((CMP_STRIDE * ci < SLC_BLOCK * (sj + 1)) &
               (CMP_STRIDE * ci + CMP_LEN > SLC_BLOCK * sj)).astype(jnp.float32)
    imp = jnp.einsum('bghsn,nj->bgsj', p_c, overlap)
    cur = (t_all // SLC_BLOCK)[:, None]
    jb = jnp.arange(nb)[None, :]
    imp = jnp.where(jb > cur, NEG, imp)
    imp = jnp.where((jb == 0) | (jb == cur - 1), FORCE, imp)
    imp = jnp.where(jb == cur, 2.0 * FORCE, imp)
    k_sel = min(SLC_TOPK, nb)
    _, sel = lax.top_k(imp, k_sel)

    ks_blocks = ks.transpose(0, 2, 1, 3).reshape(B, G, nb, SLC_BLOCK, d)
    vs_blocks = vs.transpose(0, 2, 1, 3).reshape(B, G, nb, SLC_BLOCK, d)
    n_c = S // Q_BLOCK
    q_chunks = qg.reshape(B, n_c, Q_BLOCK, G, hpg, d).transpose(1, 0, 2, 3, 4, 5)
    sel_chunks = sel.reshape(B, G, n_c, Q_BLOCK, k_sel).transpose(2, 0, 1, 3, 4)
    t_chunks = t_all.reshape(n_c, Q_BLOCK)
    gather = jax.vmap(jax.vmap(lambda blk, ix: blk[ix]))

    def select_chunk(args):
        qc, ic, tc = args
        kg = gather(ks_blocks, ic).reshape(B, G, Q_BLOCK, k_sel * SLC_BLOCK, d)
        vg = gather(vs_blocks, ic).reshape(B, G, Q_BLOCK, k_sel * SLC_BLOCK, d)
        pos = (ic[..., None] * SLC_BLOCK + jnp.arange(SLC_BLOCK)).reshape(B, G, Q_BLOCK, k_sel * SLC_BLOCK)
        mask = (pos <= tc[None, None, :, None])[:, :, None]
        sc = jnp.einsum('bqghd,bgqnd->bghqn', qc, kg).astype(jnp.float32) * scale
        p = jax.nn.softmax(jnp.where(mask, sc, NEG), axis=-1)
        return jnp.einsum('bghqn,bgqnd->bqghd', p.astype(dt), vg)

    o_slc = lax.map(select_chunk, (q_chunks, sel_chunks, t_chunks))
    o_slc = o_slc.transpose(1, 0, 2, 3, 4, 5).reshape(B, S, G, hpg, d)

    n_q = S // Q_BLOCK
    n_band = WINDOW // Q_BLOCK + 1
    kb = band_blocks(kw, n_q, n_band)
    vb = band_blocks(vw, n_q, n_band)
    qb = qg.reshape(B, n_q, Q_BLOCK, G, hpg, d)
    tpos = t_all.reshape(n_q, Q_BLOCK)[:, :, None]
    spos = (jnp.arange(n_q) * Q_BLOCK - WINDOW)[:, None, None] + jnp.arange(n_band * Q_BLOCK)[None, None, :]
    wmask = (spos <= tpos) & (spos > tpos - WINDOW) & (spos >= 0)
    s_w = jnp.einsum('bnqghd,bgnkd->bghnqk', qb, kb).astype(jnp.float32) * scale
    p_w = jax.nn.softmax(jnp.where(wmask, s_w, NEG), axis=-1)
    o_win = jnp.einsum('bghnqk,bgnkd->bnqghd', p_w.astype(dt), vb).reshape(B, S, G, hpg, d)

    g = jax.nn.sigmoid(gate_logits.astype(jnp.float32)).reshape(B, S, 3, G, hpg)[..., None].astype(dt)
    out = g[:, :, 0] * o_cmp + g[:, :, 1] * o_slc + g[:, :, 2] * o_win
    return out.reshape(B, S, H * d)


def hybrid_layer(x, c, ada_w, ada_b, norm_g, w_in, q_norm_g, kc_norm_g, ks_norm_g, kw_norm_g,
                 cmp_pe_k, cmp_w1_k, cmp_w2_k, cmp_pe_v, cmp_w1_v, cmp_w2_v, w_proj_a, w_proj_b, w_out):
    B, S, _ = x.shape
    mod = jax.nn.silu(c) @ ada_w + ada_b
    shift, scale, gate = jnp.split(mod, 3, axis=-1)
    h = rms_norm(x, norm_g) * (1 + scale[:, None]) + shift[:, None]
    proj = h @ w_in
    (sb_q, sb_k, sb_v, sb_z, n_q, k_c, v_c, k_s, v_s, k_w, v_w, n_z, n_g, m_a, m_b) = jnp.split(
        proj, np.cumsum(IN_SIZES)[:-1].tolist(), axis=-1)
    pos = jnp.arange(S)

    def heads(t, nh):
        return t.reshape(B, S, nh, HEAD_DIM)

    a = stick_breaking_attention(heads(sb_q, SB_HEADS), heads(sb_k, SB_HEADS), heads(sb_v, SB_HEADS))
    a = a.reshape(B, S, SB_WIDTH) * jax.nn.silu(sb_z)

    q = rope(rms_norm(heads(n_q, NSA_HEADS), q_norm_g), pos)
    kc = compress(heads(k_c, NSA_KV_HEADS), cmp_pe_k, cmp_w1_k, cmp_w2_k)
    kc = rope(rms_norm(kc, kc_norm_g), CMP_STRIDE * jnp.arange(kc.shape[1]) + CMP_LEN - 1)
    vc = compress(heads(v_c, NSA_KV_HEADS), cmp_pe_v, cmp_w1_v, cmp_w2_v)
    ks = rope(rms_norm(heads(k_s, NSA_KV_HEADS), ks_norm_g), pos)
    kw = rope(rms_norm(heads(k_w, NSA_KV_HEADS), kw_norm_g), pos)
    b = native_sparse_attention(q, kc, vc, ks, heads(v_s, NSA_KV_HEADS), kw, heads(v_w, NSA_KV_HEADS), n_g)
    b = b * jax.nn.silu(n_z)

    y = jax.nn.sigmoid(m_a) * (a @ w_proj_a) + jax.nn.sigmoid(m_b) * (b @ w_proj_b)
    return x + gate[:, None] * (y @ w_out)


def setup_inputs(seed: int = 0) -> dict:
    key = jax.random.key(seed)
    ks = jax.random.split(key, 24)
    L, D, d = DEPTH, D_MODEL, HEAD_DIM
    nrm = lambda k, shape, s: jax.random.normal(k, shape, jnp.float32) * s
    return {
        "x": nrm(ks[0], (BATCH, SEQ, D), 1.0),
        "c": nrm(ks[1], (BATCH, D), 1.0),
        "ada_w": nrm(ks[2], (L, D, 3 * D), 0.5 * D ** -0.5),
        "ada_b": nrm(ks[3], (L, 3 * D), 0.01),
        "norm_g": 1.0 + nrm(ks[4], (L, D), 0.02),
        "w_in": nrm(ks[5], (L, D, N_IN), D ** -0.5),
        "q_norm_g": 1.0 + nrm(ks[6], (L, d), 0.02),
        "kc_norm_g": 1.0 + nrm(ks[7], (L, d), 0.02),
        "ks_norm_g": 1.0 + nrm(ks[8], (L, d), 0.02),
        "kw_norm_g": 1.0 + nrm(ks[9], (L, d), 0.02),
        "cmp_pe_k": nrm(ks[10], (L, CMP_LEN, d), 0.1),
        "cmp_w1_k": nrm(ks[11], (L, CMP_LEN * d, CMP_HIDDEN), (CMP_LEN * d) ** -0.5),
        "cmp_w2_k": nrm(ks[12], (L, CMP_HIDDEN, d), CMP_HIDDEN ** -0.5),
        "cmp_pe_v": nrm(ks[13], (L, CMP_LEN, d), 0.1),
        "cmp_w1_v": nrm(ks[14], (L, CMP_LEN * d, CMP_HIDDEN), (CMP_LEN * d) ** -0.5),
        "cmp_w2_v": nrm(ks[15], (L, CMP_HIDDEN, d), CMP_HIDDEN ** -0.5),
        "w_proj_a": nrm(ks[16], (L, SB_WIDTH, D), SB_WIDTH ** -0.5),
        "w_proj_b": nrm(ks[17], (L, NSA_WIDTH, D), NSA_WIDTH ** -0.5),
        "w_out": nrm(ks[18], (L, D, D), D ** -0.5),
    }


def reference(x, c, ada_w, ada_b, norm_g, w_in, q_norm_g, kc_norm_g, ks_norm_g, kw_norm_g,
              cmp_pe_k, cmp_w1_k, cmp_w2_k, cmp_pe_v, cmp_w1_v, cmp_w2_v, w_proj_a, w_proj_b, w_out):
    for l in range(DEPTH):
        x = hybrid_layer(x, c, ada_w[l], ada_b[l], norm_g[l], w_in[l], q_norm_g[l], kc_norm_g[l],
                         ks_norm_g[l], kw_norm_g[l], cmp_pe_k[l], cmp_w1_k[l], cmp_w2_k[l],
                         cmp_pe_v[l], cmp_w1_v[l], cmp_w2_v[l], w_proj_a[l], w_proj_b[l], w_out[l])
    return x
```

```cpp
#include <hip/hip_runtime.h>
#include <hip/hip_cooperative_groups.h>
#include <cstdio>
#include <cstdint>
namespace cg = cooperative_groups;
namespace pg8 {
#define PG8_LAS __attribute__((address_space(3)))
typedef unsigned short bf16_t;
typedef short bf16x8 __attribute__((ext_vector_type(8)));
typedef float f32x4 __attribute__((ext_vector_type(4)));
typedef unsigned u32x4 __attribute__((ext_vector_type(4)));
constexpr int BM = 256, BK = 64, HALF = 128, HTB = HALF * BK * 2  , STAGE_BYTES = 8 * HTB, NXCD = 8, WGM = 8;

__host__ __device__ __forceinline__ int lds_byte(int r, int c) { const int st = (r >> 4) * 2 + (c >> 5), rr = r & 15, cc = c & 31, ob = rr * 64 + cc * 2; return st * 1024 + (ob ^ (((ob >> 9) & 1) << 5)); }
__host__ __device__ __forceinline__ void stage_rc(int b, int& R, int& C) { const int st = b / 1024, sb = b % 1024, swz = sb ^ (((sb >> 9) & 1) << 5); R = (st >> 1) * 16 + swz / 64; C = (st & 1) * 32 + (swz % 64) / 2; }
__host__ __device__ __forceinline__ int perm32(int rho) { const int n = rho >> 4, i = rho & 15; return 8 * (i >> 2) + 4 * n + (i & 3); }

struct Unit { int pm, pn; };
struct Gemm { const bf16_t* A; const bf16_t* Bt; int M, N, K; };

struct StaticOrder {
    int nM, nN, nwg, G, c;
    __host__ __device__ void init(int M, int N, int G_, int c_) { nM = M / BM; nN = N / BM; nwg = nM * nN; G = G_; c = c_; }
    __host__ __device__ bool next(int i, Unit& u) const {
        const long L = (long)i * G + c; if (L >= nwg) return false;
        int wgid = (int)L; { const int q = nwg / NXCD, r = nwg % NXCD, xcd = wgid % NXCD, off = wgid / NXCD; wgid = (xcd < r ? xcd * (q + 1) : r * (q + 1) + (xcd - r) * q) + off; }
        const int nig = WGM * nN, gid = wgid / nig, fm = gid * WGM, gsz = (nM - fm) < WGM ? (nM - fm) : WGM;
        u.pm = fm + ((wgid % nig) % gsz); u.pn = (wgid % nig) / gsz; return true;
    }
    __device__ __forceinline__ void a_ready(const Unit&) const {}
    __device__ __forceinline__ void done(const Unit&) const {}
};

__device__ __forceinline__ unsigned cvt_pk_bf16(float lo, float hi) { unsigned r; asm volatile("v_cvt_pk_bf16_f32 %0, %1, %2" : "=v"(r) : "v"(lo), "v"(hi)); return r; }
typedef float f32x2 __attribute__((ext_vector_type(2)));
__device__ __forceinline__ f32x2 gelu_pk(f32x2 v) {
    const f32x2 av = __builtin_elementwise_abs(v), d = av * 0.2316418882f + 1.0f;
    f32x2 t; t.x = __builtin_amdgcn_rcpf(d.x); t.y = __builtin_amdgcn_rcpf(d.y);
    f32x2 q = t * 0.5307027145f + (-0.7265760135f); q = q * t + 0.7107068705f; q = q * t + (-0.142248368f); q = q * t + 0.127414796f; q = q * t;
    const f32x2 s = (v * v) * (-0.72134752044f);
    f32x2 e; e.x = __builtin_amdgcn_exp2f(s.x); e.y = __builtin_amdgcn_exp2f(s.y);
    const f32x2 m = v * (q * e), r = v - m;
    f32x2 o; o.x = v.x < 0.f ? m.x : r.x; o.y = v.y < 0.f ? m.y : r.y; return o;
}

template <int ACT  > struct EpiBf16 {
    static constexpr bool PERM = true, AFTER_DRAIN = false; static_assert(ACT == 0 || ACT == 1, "EpiBf16: ACT is 0 (none) or 1 (gelu_pk)");
    bf16_t* O; int ldc; const float* bias; int split_cols; size_t split_stride; float scale0;
    __device__ __forceinline__ void operator()(const f32x4 (&acc)[2][2][4][2], const Unit& u, int wr, int wc, int fr, int fq) const {
        const int row0 = u.pm * BM + wr * 64 + fr; int colt = u.pn * BM; bf16_t* base = O;
        float sc = 1.f; if (split_cols) { const int t = colt / split_cols; base += (size_t)t * split_stride; colt -= t * split_cols; if (t == 0) sc = scale0; }
        const int col0 = colt + wc * 32 + 8 * fq, bcol0 = u.pn * BM + wc * 32 + 8 * fq;
        f32x4 bv[2][2];
#pragma unroll
        for (int bj = 0; bj < 2; ++bj)
#pragma unroll
            for (int n = 0; n < 2; ++n) bv[bj][n] = bias ? *(const f32x4*)(bias + bcol0 + bj * HALF + 4 * n) : (f32x4){0.f, 0.f, 0.f, 0.f};
#pragma unroll
        for (int ai = 0; ai < 2; ++ai)
#pragma unroll
            for (int m = 0; m < 4; ++m) { bf16_t* rowp = base + (size_t)(row0 + ai * HALF + m * 16) * ldc + col0;
#pragma unroll
                for (int bj = 0; bj < 2; ++bj) { f32x4 v0 = acc[ai][bj][m][0] + bv[bj][0], v1 = acc[ai][bj][m][1] + bv[bj][1];
                    if (ACT == 1) { f32x2 a = gelu_pk((f32x2){v0[0], v0[1]}), b = gelu_pk((f32x2){v0[2], v0[3]}), c = gelu_pk((f32x2){v1[0], v1[1]}), d = gelu_pk((f32x2){v1[2], v1[3]});
                        v0 = (f32x4){a.x, a.y, b.x, b.y}; v1 = (f32x4){c.x, c.y, d.x, d.y}; }
                    v0 = v0 * sc; v1 = v1 * sc; u32x4 w; w.x = cvt_pk_bf16(v0[0], v0[1]); w.y = cvt_pk_bf16(v0[2], v0[3]); w.z = cvt_pk_bf16(v1[0], v1[1]); w.w = cvt_pk_bf16(v1[2], v1[3]);
                    *(u32x4*)(rowp + bj * HALF) = w; } }
    }
};

struct PanelStats {
    unsigned* xbuf;
    unsigned* cnt;
    unsigned* tmo;
    int ntn; float eps;
    unsigned code;
    __device__ __forceinline__ bool run(const f32x4 (&v)[2][2][4][2], const Unit& u, int wr, int wc, int fr, int fq, PG8_LAS unsigned char* lds, int wid, int lane) const {
        typedef float f32x2v __attribute__((ext_vector_type(2)));
        PG8_LAS f32x2v* P = (PG8_LAS f32x2v*)lds;
        PG8_LAS f32x2v* S = (PG8_LAS f32x2v*)(lds + 8192);
        PG8_LAS unsigned* flag = (PG8_LAS unsigned*)(lds + 8192 + 2048);
#pragma unroll
        for (int ai = 0; ai < 2; ++ai)
#pragma unroll
            for (int m = 0; m < 4; ++m) {
                float s = 0.f;
#pragma unroll
                for (int bj = 0; bj < 2; ++bj)
#pragma unroll
                    for (int n = 0; n < 2; ++n) { const f32x4 x = v[ai][bj][m][n]; s += (x[0] + x[1]) + (x[2] + x[3]); }
                s += __shfl_xor(s, 16); s += __shfl_xor(s, 32);
                const float mw = s * (1.0f / 64.0f); float q = 0.f;
#pragma unroll
                for (int bj = 0; bj < 2; ++bj)
#pragma unroll
                    for (int n = 0; n < 2; ++n) { const f32x4 d = v[ai][bj][m][n] - mw; q += (d[0] * d[0] + d[1] * d[1]) + (d[2] * d[2] + d[3] * d[3]); }
                q += __shfl_xor(q, 16); q += __shfl_xor(q, 32);
                if (fq == 0) P[(ai * HALF + wr * 64 + m * 16 + fr) * 4 + wc] = (f32x2v){mw, q};
            }
        asm volatile("s_waitcnt lgkmcnt(0)" ::: "memory"); __builtin_amdgcn_s_barrier(); asm volatile("" ::: "memory");
#if defined(BROKEN_EXCHANGE_NO_WAIT)
#warning BROKEN CONTROL BUILD: the row-statistics exchange does not wait; results are wrong by design
        if (blockIdx.x >= 64) { const long long t0_ = clock64(); while (clock64() - t0_ < 60000) __builtin_amdgcn_s_sleep(8); }
#endif
        const int row = wid * 32 + (lane & 31);
        if (lane < 32) {
            const f32x2v a = P[row * 4 + 0], b = P[row * 4 + 1], c = P[row * 4 + 2], d = P[row * 4 + 3];
            const float mt = (a.x + b.x + c.x + d.x) * 0.25f;
            const float da = a.x - mt, db = b.x - mt, dc = c.x - mt, dd = d.x - mt;
            const float m2 = (a.y + b.y) + (c.y + d.y) + 64.0f * ((da * da + db * db) + (dc * dc + dd * dd));
            unsigned long long* slot = (unsigned long long*)xbuf + ((size_t)(u.pm * BM + row) * 4 + u.pn);
            __hip_atomic_store(slot, ((unsigned long long)__float_as_uint(m2) << 32) | __float_as_uint(mt), __ATOMIC_RELAXED, __HIP_MEMORY_SCOPE_AGENT);
        }
        asm volatile("s_waitcnt vmcnt(0)" ::: "memory");
        if (lane == 0) __hip_atomic_fetch_add(cnt + 64 * u.pm, 1u, __ATOMIC_RELAXED, __HIP_MEMORY_SCOPE_AGENT);
        if (wid == 0) {
            bool dead = false; const unsigned long long t0 = __builtin_amdgcn_s_memrealtime(); const unsigned want = 8u * (unsigned)ntn;
            for (;;) {
#if defined(BROKEN_EXCHANGE_NO_WAIT)
                break;
#endif
                if ((unsigned)__builtin_amdgcn_readfirstlane(__hip_atomic_load(cnt + 64 * u.pm, __ATOMIC_RELAXED, __HIP_MEMORY_SCOPE_AGENT)) >= want) break;
                if (__builtin_amdgcn_s_memrealtime() - t0 > 2000000ull) {
                    if (lane == 0) { unsigned expect = 0u; __hip_atomic_compare_exchange_strong(tmo + 1, &expect, code | (unsigned)(u.pm & 0xff), __ATOMIC_RELAXED, __ATOMIC_RELAXED, __HIP_MEMORY_SCOPE_AGENT);
                                     __hip_atomic_store(tmo, 1u, __ATOMIC_RELAXED, __HIP_MEMORY_SCOPE_AGENT); }
                    dead = true; break; }
                __builtin_amdgcn_s_sleep(2);
            }
            __builtin_amdgcn_fence(__ATOMIC_ACQUIRE, "agent");
            if (lane == 0) flag[0] = dead ? 1u : 0u;
        }
        asm volatile("s_waitcnt vmcnt(0) lgkmcnt(0)" ::: "memory"); __builtin_amdgcn_s_barrier(); asm volatile("" ::: "memory");
        const bool bad = flag[0] != 0u;
        if (lane < 32) {
            const unsigned long long* slot = (const unsigned long long*)xbuf + (size_t)(u.pm * BM + row) * 4; float mt[4], m2[4]; float ms = 0.f;
#pragma unroll
            for (int t = 0; t < 4; ++t) { if (t < ntn) { const unsigned long long w = __hip_atomic_load(slot + t, __ATOMIC_RELAXED, __HIP_MEMORY_SCOPE_AGENT); mt[t] = __uint_as_float((unsigned)w); m2[t] = __uint_as_float((unsigned)(w >> 32)); } else { mt[t] = 0.f; m2[t] = 0.f; } ms += mt[t]; }
            const float mean = ms / (float)ntn; float q = 0.f;
#pragma unroll
            for (int t = 0; t < 4; ++t) if (t < ntn) { const float dm = mt[t] - mean; q += m2[t] + 256.0f * dm * dm; }
            S[row] = (f32x2v){mean, 1.0f / sqrtf(q / (256.0f * (float)ntn) + eps)};
        }
        asm volatile("s_waitcnt lgkmcnt(0)" ::: "memory"); __builtin_amdgcn_s_barrier(); asm volatile("" ::: "memory");
        return bad;
    }
};
struct EpiLnRes {
    static constexpr bool PERM = false, AFTER_DRAIN = true;
    const float* base; float* out; int ldc; const float* bias; PanelStats st; unsigned poison;
    __device__ __forceinline__ void fused(f32x4 (&acc)[2][2][4][2], const Unit& u, int wr, int wc, int fr, int fq, PG8_LAS unsigned char* lds, int wid, int lane) const {
        typedef float f32x2v __attribute__((ext_vector_type(2)));
        const PG8_LAS f32x2v* S = (const PG8_LAS f32x2v*)(lds + 8192);
        const int col0 = u.pn * BM + wc * 32 + 4 * fq;
#pragma unroll
        for (int bj = 0; bj < 2; ++bj)
#pragma unroll
            for (int n = 0; n < 2; ++n) { const f32x4 bv = bias ? *(const f32x4*)(bias + col0 + bj * HALF + n * 16) : (f32x4){0.f, 0.f, 0.f, 0.f};
#pragma unroll
                for (int ai = 0; ai < 2; ++ai)
#pragma unroll
                    for (int m = 0; m < 4; ++m) acc[ai][bj][m][n] += bv; }
        f32x4 pre[4][2][2];
#pragma unroll
        for (int m = 0; m < 4; ++m) { const size_t off = (size_t)(u.pm * BM + wr * 64 + m * 16 + fr) * ldc + col0;
#pragma unroll
            for (int bj = 0; bj < 2; ++bj)
#pragma unroll
                for (int n = 0; n < 2; ++n) pre[m][bj][n] = *(const f32x4*)(base + off + bj * HALF + n * 16); }
        const bool bad = st.run(acc, u, wr, wc, fr, fq, lds, wid, lane) || poison != 0u;
        const float qnan = __builtin_nanf("");
#pragma unroll
        for (int ai = 0; ai < 2; ++ai)
#pragma unroll
            for (int m = 0; m < 4; ++m) { const int r = ai * HALF + wr * 64 + m * 16 + fr; const f32x2v sr = S[r]; const size_t off = (size_t)(u.pm * BM + r) * ldc + col0;
#pragma unroll
                for (int bj = 0; bj < 2; ++bj)
#pragma unroll
                    for (int n = 0; n < 2; ++n) { const f32x4 bs = ai == 0 ? pre[m][bj][n] : *(const f32x4*)(base + off + bj * HALF + n * 16); f32x4 o = bs + (acc[ai][bj][m][n] - sr.x) * sr.y;
                        if (bad) o = (f32x4){qnan, qnan, qnan, qnan}; *(f32x4*)(out + off + bj * HALF + n * 16) = o; }
                if (m & 1) asm volatile("" ::: "memory"); }
    }
};
struct EpiLnResLn {
    static constexpr bool PERM = false, AFTER_DRAIN = true;
    const float* base; float* out; bf16_t* xn; int ldc; const float* bias; PanelStats st1, st2; unsigned poison;
    __device__ __forceinline__ void fused(f32x4 (&acc)[2][2][4][2], const Unit& u, int wr, int wc, int fr, int fq, PG8_LAS unsigned char* lds, int wid, int lane) const {
        typedef float f32x2v __attribute__((ext_vector_type(2))); typedef unsigned u32x2v __attribute__((ext_vector_type(2)));
        const PG8_LAS f32x2v* S = (const PG8_LAS f32x2v*)(lds + 8192);
        const int col0 = u.pn * BM + wc * 32 + 4 * fq;
#pragma unroll
        for (int bj = 0; bj < 2; ++bj)
#pragma unroll
            for (int n = 0; n < 2; ++n) { const f32x4 bv = bias ? *(const f32x4*)(bias + col0 + bj * HALF + n * 16) : (f32x4){0.f, 0.f, 0.f, 0.f};
#pragma unroll
                for (int ai = 0; ai < 2; ++ai)
#pragma unroll
                    for (int m = 0; m < 4; ++m) acc[ai][bj][m][n] += bv; }
        bool bad = st1.run(acc, u, wr, wc, fr, fq, lds, wid, lane) || poison != 0u;
        const float qnan = __builtin_nanf("");
#pragma unroll
        for (int ai = 0; ai < 2; ++ai)
#pragma unroll
            for (int m = 0; m < 4; ++m) { const int r = ai * HALF + wr * 64 + m * 16 + fr; const f32x2v sr = S[r]; const size_t off = (size_t)(u.pm * BM + r) * ldc + col0;
#pragma unroll
                for (int bj = 0; bj < 2; ++bj)
#pragma unroll
                    for (int n = 0; n < 2; ++n) { const f32x4 bs = *(const f32x4*)(base + off + bj * HALF + n * 16); acc[ai][bj][m][n] = bs + (acc[ai][bj][m][n] - sr.x) * sr.y; }
                asm volatile("" : "+v"(acc[ai][0][m][0]), "+v"(acc[ai][0][m][1]), "+v"(acc[ai][1][m][0]), "+v"(acc[ai][1][m][1]));
                if (m & 1) asm volatile("" ::: "memory"); }
        const bool bad1 = bad;
        bad = st2.run(acc, u, wr, wc, fr, fq, lds, wid, lane) || bad;
#pragma unroll
        for (int ai = 0; ai < 2; ++ai)
#pragma unroll
            for (int m = 0; m < 4; ++m) { const int r = ai * HALF + wr * 64 + m * 16 + fr; const f32x2v sr = S[r]; const size_t off = (size_t)(u.pm * BM + r) * ldc + col0;
#pragma unroll
                for (int bj = 0; bj < 2; ++bj)
#pragma unroll
                    for (int n = 0; n < 2; ++n) { const f32x4 x1 = acc[ai][bj][m][n]; *(f32x4*)(out + off + bj * HALF + n * 16) = bad1 ? (f32x4){qnan, qnan, qnan, qnan} : x1;
                        const f32x4 o = (x1 - sr.x) * sr.y; u32x2v w; w.x = cvt_pk_bf16(o[0], o[1]); w.y = cvt_pk_bf16(o[2], o[3]);
                        if (bad) { w.x = 0x7fc07fc0u; w.y = 0x7fc07fc0u; } *(u32x2v*)(xn + off + bj * HALF + n * 16) = w; }
                asm volatile("" ::: "memory"); }
    }
};

template <class Epi, class Sched, bool ALIGN_EPI = false, bool SP2 = false>
__device__ __forceinline__ void gemm_phase(PG8_LAS unsigned char* lds, const Gemm g, const Sched& S, const Epi& E, int tid_in) {
    int tid_l = tid_in; asm volatile("" : "+v"(tid_l));
    const int tid = tid_l, wid = __builtin_amdgcn_readfirstlane(tid >> 6), lane = tid & 63, wr = wid >> 2, wc = wid & 3, fr = lane & 15, fq = lane >> 4;
    const int K = g.K, nt = K / BK;
    unsigned voffA[2], voffB[2];
#pragma unroll
    for (int i = 0; i < 2; ++i) { int R, C; stage_rc(tid * 16 + i * 8192, R, C); const int Rb = Epi::PERM ? ((R & ~31) + perm32(R & 31)) : R;
        voffA[i] = (unsigned)(R * K + C) * 2u; voffB[i] = (unsigned)(Rb * K + C) * 2u; }
    const size_t kstep = (size_t)(BK * 2);
    const size_t hstep = (size_t)HALF * K * 2;
    const size_t tstep = 2 * hstep;
    const unsigned ldsw = (unsigned)wid * 1024u;
    const int aoff = lds_byte(wr * 64 + fr, fq * 8), boff = lds_byte(wc * 32 + fr, fq * 8);
#define PG8_SA(b, h) (((b) * 2 + (h)) * HTB)
#define PG8_SB(b, h) ((4 + (b) * 2 + (h)) * HTB)
#define PG8_STAGE(bufoff, gbase, voff) do { _Pragma("unroll") for (int _i = 0; _i < 2; ++_i) \
        __builtin_amdgcn_global_load_lds((const unsigned*)((const char*)(gbase) + (voff)[_i]), (PG8_LAS unsigned*)(lds + (bufoff) + ldsw + _i * 8192), 16, 0, 0); } while (0)
#define PG8_LDA(dst, b, h) do { _Pragma("unroll") for (int m = 0; m < 4; ++m) _Pragma("unroll") for (int k = 0; k < 2; ++k) dst[m][k] = *(const PG8_LAS bf16x8*)(lds + PG8_SA(b, h) + aoff + m * 2048 + k * 1024); } while (0)
#define PG8_LDB(dst, b, h) do { _Pragma("unroll") for (int n = 0; n < 2; ++n) _Pragma("unroll") for (int k = 0; k < 2; ++k) dst[n][k] = *(const PG8_LAS bf16x8*)(lds + PG8_SB(b, h) + boff + n * 2048 + k * 1024); } while (0)
#define PG8_MMA(ai, bj, At, Bt) do { __builtin_amdgcn_s_setprio(1); _Pragma("unroll") for (int m = 0; m < 4; ++m) _Pragma("unroll") for (int n = 0; n < 2; ++n) _Pragma("unroll") for (int k = 0; k < 2; ++k) \
        acc[ai][bj][m][n] = __builtin_amdgcn_mfma_f32_16x16x32_bf16(Bt[n][k], At[m][k], acc[ai][bj][m][n], 0, 0, 0); __builtin_amdgcn_s_setprio(0); } while (0)
#define PG8_WAIT_V(n) asm volatile("s_waitcnt vmcnt(" #n ")" ::: "memory")
#define PG8_WAIT_L(n) asm volatile("s_waitcnt lgkmcnt(" #n ")" ::: "memory")
#define PG8_BAR __builtin_amdgcn_s_barrier()
#define PG8_SCHED __builtin_amdgcn_sched_barrier(0)
    Unit cur, nxt; int ui = 0;
    if (!S.next(0, cur)) return;
    f32x4 acc[2][2][4][2];
#pragma unroll
    for (int a = 0; a < 2; ++a)
#pragma unroll
        for (int b = 0; b < 2; ++b)
#pragma unroll
            for (int m = 0; m < 4; ++m)
#pragma unroll
                for (int n = 0; n < 2; ++n) acc[a][b][m][n] = (f32x4){0.f, 0.f, 0.f, 0.f};
    bf16x8 At[4][2], B0[2][2], B1[2][2];
    const char* cA = (const char*)g.A + (size_t)cur.pm * tstep; const char* cB = (const char*)g.Bt + (size_t)cur.pn * tstep;
    S.a_ready(cur);
    if constexpr (SP2) {
        PG8_STAGE(PG8_SB(0, 0), cB, voffB); PG8_STAGE(PG8_SB(0, 1), cB + hstep, voffB); PG8_STAGE(PG8_SA(0, 0), cA, voffA); PG8_STAGE(PG8_SA(0, 1), cA + hstep, voffA);
        if (wr == 1) PG8_BAR;
        PG8_WAIT_V(2); PG8_BAR;
        PG8_STAGE(PG8_SB(1, 0), cB + kstep, voffB); PG8_STAGE(PG8_SA(1, 0), cA + kstep, voffA); PG8_STAGE(PG8_SB(1, 1), cB + hstep + kstep, voffB);
        PG8_WAIT_V(6); PG8_BAR;
    } else {
        PG8_STAGE(PG8_SB(0, 0), cB, voffB); PG8_STAGE(PG8_SA(0, 0), cA, voffA); PG8_STAGE(PG8_SB(0, 1), cB + hstep, voffB); PG8_STAGE(PG8_SA(0, 1), cA + hstep, voffA);
        if (wr == 1) PG8_BAR;
        PG8_WAIT_V(4); PG8_BAR;
        PG8_STAGE(PG8_SB(1, 0), cB + kstep, voffB); PG8_STAGE(PG8_SA(1, 0), cA + kstep, voffA); PG8_STAGE(PG8_SB(1, 1), cB + hstep + kstep, voffB);
        PG8_WAIT_V(6); PG8_BAR;
    }
    for (;;) {
        const bool has_next = S.next(ui + 1, nxt);
        const char* nA = has_next ? (const char*)g.A + (size_t)nxt.pm * tstep : cA; const char* nB = has_next ? (const char*)g.Bt + (size_t)nxt.pn * tstep : cB;
        for (int t = 0; t < nt; t += 2) {
            const bool last = (t == nt - 2);
            const char* a1 = cA + (size_t)(t + 1) * kstep;
            const char* a2 = last ? nA : cA + (size_t)(t + 2) * kstep; const char* b2 = last ? nB : cB + (size_t)(t + 2) * kstep;
            const char* a3 = a2 + kstep; const char* b3 = b2 + kstep;
            if (last && has_next) S.a_ready(nxt);
            if constexpr (SP2) {
            PG8_LDB(B0, 0, 0); PG8_LDB(B1, 0, 1); PG8_SCHED; PG8_LDA(At, 0, 0); PG8_STAGE(PG8_SA(1, 1), a1 + hstep, voffA);
            PG8_WAIT_V(8); PG8_WAIT_L(0); PG8_BAR; PG8_MMA(0, 0, At, B0); PG8_MMA(0, 1, At, B1); PG8_BAR; PG8_SCHED;
            PG8_LDA(At, 0, 1); PG8_STAGE(PG8_SB(0, 0), b2, voffB); PG8_STAGE(PG8_SB(0, 1), b2 + hstep, voffB); PG8_STAGE(PG8_SA(0, 0), a2, voffA);
            PG8_WAIT_V(8); PG8_WAIT_L(0); PG8_BAR; PG8_MMA(1, 0, At, B0); PG8_MMA(1, 1, At, B1); PG8_BAR; PG8_SCHED;
            PG8_LDB(B0, 1, 0); PG8_LDB(B1, 1, 1); PG8_SCHED; PG8_LDA(At, 1, 0); PG8_STAGE(PG8_SA(0, 1), a2 + hstep, voffA);
            PG8_WAIT_V(8); PG8_WAIT_L(0); PG8_BAR; PG8_MMA(0, 0, At, B0); PG8_MMA(0, 1, At, B1); PG8_BAR; PG8_SCHED;
            PG8_LDA(At, 1, 1); PG8_STAGE(PG8_SB(1, 0), b3, voffB); PG8_STAGE(PG8_SB(1, 1), b3 + hstep, voffB); PG8_STAGE(PG8_SA(1, 0), a3, voffA);
            PG8_WAIT_V(8); PG8_WAIT_L(0); PG8_BAR; PG8_MMA(1, 0, At, B0); PG8_MMA(1, 1, At, B1); PG8_BAR; PG8_SCHED;
            } else {
            PG8_LDB(B0, 0, 0); PG8_SCHED; PG8_LDA(At, 0, 0); PG8_STAGE(PG8_SA(1, 1), a1 + hstep, voffA);
            PG8_WAIT_L(8); PG8_BAR; PG8_WAIT_L(0); PG8_MMA(0, 0, At, B0); PG8_BAR; PG8_SCHED;
            PG8_LDB(B1, 0, 1); PG8_STAGE(PG8_SB(0, 0), b2, voffB);
            PG8_BAR; PG8_WAIT_L(0); PG8_MMA(0, 1, At, B1); PG8_BAR;
            PG8_LDA(At, 0, 1); PG8_STAGE(PG8_SA(0, 0), a2, voffA);
            PG8_BAR; PG8_WAIT_L(0); PG8_MMA(1, 0, At, B0); PG8_BAR; PG8_SCHED;
            PG8_STAGE(PG8_SB(0, 1), b2 + hstep, voffB);
            PG8_WAIT_V(6); PG8_BAR; PG8_MMA(1, 1, At, B1); PG8_BAR;
            PG8_LDB(B0, 1, 0); PG8_SCHED; PG8_LDA(At, 1, 0); PG8_STAGE(PG8_SA(0, 1), a2 + hstep, voffA);
            PG8_WAIT_L(8); PG8_BAR; PG8_WAIT_L(0); PG8_MMA(0, 0, At, B0); PG8_BAR; PG8_SCHED;
            PG8_LDB(B1, 1, 1); PG8_STAGE(PG8_SB(1, 0), b3, voffB);
            PG8_BAR; PG8_WAIT_L(0); PG8_MMA(0, 1, At, B1); PG8_BAR;
            PG8_LDA(At, 1, 1); PG8_STAGE(PG8_SA(1, 0), a3, voffA);
            PG8_BAR; PG8_WAIT_L(0); PG8_MMA(1, 0, At, B0); PG8_BAR; PG8_SCHED;
            PG8_STAGE(PG8_SB(1, 1), b3 + hstep, voffB);
            PG8_WAIT_V(6); PG8_BAR; PG8_MMA(1, 1, At, B1); PG8_BAR;
            }
        }
        if constexpr (ALIGN_EPI) { if (wr == 0) PG8_BAR; }
        if constexpr (!Epi::AFTER_DRAIN) { E(acc, cur, wr, wc, fr, fq); S.done(cur); }
        if (!has_next) break;
#pragma unroll
        for (int a = 0; a < 2; ++a)
#pragma unroll
            for (int b = 0; b < 2; ++b)
#pragma unroll
                for (int m = 0; m < 4; ++m)
#pragma unroll
                    for (int n = 0; n < 2; ++n) acc[a][b][m][n] = (f32x4){0.f, 0.f, 0.f, 0.f};
        cur = nxt; cA = nA; cB = nB; ++ui;
        if constexpr (ALIGN_EPI) { if (wr == 1) PG8_BAR; }
    }
    PG8_WAIT_V(0);
    if constexpr (!ALIGN_EPI) { if (wr == 0) PG8_BAR; }
    PG8_BAR;
    if constexpr (Epi::AFTER_DRAIN) { E.fused(acc, cur, wr, wc, fr, fq, lds, wid, lane); S.done(cur); }
#undef PG8_SA
#undef PG8_SB
#undef PG8_STAGE
#undef PG8_LDA
#undef PG8_LDB
#undef PG8_MMA
#undef PG8_WAIT_V
#undef PG8_WAIT_L
#undef PG8_BAR
#undef PG8_SCHED
}
}

#define LAS __attribute__((address_space(3)))
typedef unsigned short bf16_t;
typedef short bf16x8 __attribute__((ext_vector_type(8)));
typedef short s16x4 __attribute__((ext_vector_type(4)));
typedef float f32x16 __attribute__((ext_vector_type(16)));
typedef float f32x4 __attribute__((ext_vector_type(4)));
typedef float f32x2 __attribute__((ext_vector_type(2)));
typedef unsigned u32x4 __attribute__((ext_vector_type(4)));
typedef unsigned u32x2 __attribute__((ext_vector_type(2)));

constexpr int DM = 1024, NBATCH = 8, SEQ = 2048, MTOK = NBATCH * SEQ, DEPTH = 4, NIN = 5912, NINP = 6144;
constexpr float RMS_EPS = 1e-6f, NEGF = -1e30f;
constexpr size_t MiB = 1u << 20;
constexpr size_t WS_MOD = 0;
constexpr size_t WS_ROPE = 1 * MiB;
constexpr size_t WS_W2T = 2 * MiB;
constexpr size_t WS_KC = 2 * MiB + 256 * 1024;
constexpr size_t WS_VC = 2 * MiB + 512 * 1024;
constexpr size_t WS_NG = 3 * MiB;
constexpr size_t WS_W1T = 5 * MiB;
constexpr size_t WS_WAT = 9 * MiB;
constexpr size_t WS_WBT = 13 * MiB;
constexpr size_t WS_WOT = 17 * MiB;
constexpr size_t WS_WINT = 25 * MiB;
constexpr size_t WS_H = 73 * MiB;
constexpr size_t WS_Y = WS_H;
constexpr size_t WS_SBQ = 105 * MiB, WS_SBK = 121 * MiB, WS_SBV = 137 * MiB, WS_NQ = 153 * MiB;
constexpr size_t WS_YA = WS_SBQ;
constexpr size_t WS_SBZ = 169 * MiB, WS_NZ = 185 * MiB;
constexpr size_t WS_MA = 201 * MiB, WS_MB = 233 * MiB;
constexpr size_t WS_KCR = 265 * MiB, WS_VCR = 269 * MiB, WS_KS = 273 * MiB, WS_VS = 277 * MiB, WS_KW = 281 * MiB, WS_VW = 285 * MiB;
constexpr size_t WS_AACT = 289 * MiB, WS_BACT = 305 * MiB;
constexpr size_t WS_END = 321 * MiB;
constexpr int LDS_BYTES = 131072 + 4096;

struct Args { const float* in[19]; float* out; unsigned char* ws; int ph_lo, ph_hi; };

__device__ __forceinline__ unsigned f2bf(float f) { unsigned u = __builtin_bit_cast(unsigned, f); return (u + 0x7fffu + ((u >> 16) & 1u)) >> 16; }
__device__ __forceinline__ unsigned pk2(float lo, float hi) { return pg8::cvt_pk_bf16(lo, hi); }
__device__ __forceinline__ float bf_lo(unsigned w) { return __builtin_bit_cast(float, w << 16); }
__device__ __forceinline__ float bf_hi(unsigned w) { return __builtin_bit_cast(float, w & 0xffff0000u); }
__device__ __forceinline__ float sigmoidf_(float x) { return __builtin_amdgcn_rcpf(1.0f + __expf(-x)); }
__device__ __forceinline__ float siluf_(float x) { return x * sigmoidf_(x); }
__device__ __forceinline__ float wave_sum(float v) {
#pragma unroll
    for (int o = 1; o < 64; o <<= 1) v += __shfl_xor(v, o);
    return v;
}
#define LDS_WAIT() asm volatile("s_waitcnt lgkmcnt(0)" ::: "memory")

__device__ __forceinline__ void transpose_item(const float* W, int ldw, int n0, int nvalid, bf16_t* WT, int K, int k0, int dstrow0, LAS float* scr, int lane) {
    const int cidx = lane & 31;
#pragma unroll 8
    for (int i = 0; i < 32; ++i) { const int kk = 2 * i + (lane >> 5); float v = 0.f; if (cidx < nvalid) v = W[(size_t)(k0 + kk) * ldw + n0 + cidx]; scr[kk * 33 + cidx] = v; }
    LDS_WAIT();
    const int c = lane & 7;
#pragma unroll
    for (int j = 0; j < 4; ++j) { const int n = (lane >> 3) + 8 * j; const LAS float* s = scr + (8 * c) * 33 + n;
        u32x4 o; o.x = pk2(s[0 * 33], s[1 * 33]); o.y = pk2(s[2 * 33], s[3 * 33]); o.z = pk2(s[4 * 33], s[5 * 33]); o.w = pk2(s[6 * 33], s[7 * 33]);
        *(u32x4*)(WT + (size_t)(dstrow0 + n) * K + k0 + 8 * c) = o; }
    LDS_WAIT();
}

__device__ __forceinline__ void phase0(const Args& a, unsigned char* ws, LAS unsigned char* L, int tid, int lane, int wid) {
    {
        LAS float* sc = (LAS float*)L; LAS float* red = (LAS float*)(L + 32768);
        const float* c = a.in[1]; const float* ada_w = a.in[2]; const float* ada_b = a.in[3]; float* mod = (float*)(ws + WS_MOD);
        if ((int)blockIdx.x < 192) {
            for (int i = tid; i < 8192; i += 512) sc[i] = siluf_(c[i]);
            __syncthreads();
        }
        for (int u = blockIdx.x; u < 192; u += gridDim.x) {
            const int l = u / 48, cgp = u % 48, col = cgp * 64 + (tid & 63), ks = tid >> 6;
            float acc[8];
#pragma unroll
            for (int b = 0; b < 8; ++b) acc[b] = 0.f;
            const float* wp = ada_w + ((size_t)l * 1024 + ks * 128) * 3072 + col;
#pragma unroll 4
            for (int k = 0; k < 128; ++k) { const float w = wp[(size_t)k * 3072];
#pragma unroll
                for (int b = 0; b < 8; ++b) acc[b] += sc[b * 1024 + ks * 128 + k] * w; }
#pragma unroll
            for (int b = 0; b < 8; ++b) red[(ks * 8 + b) * 64 + (tid & 63)] = acc[b];
            __syncthreads();
            { const int b = tid >> 6, cc = tid & 63; float s = 0.f;
#pragma unroll
              for (int k2 = 0; k2 < 8; ++k2) s += red[(k2 * 8 + b) * 64 + cc];
              mod[((size_t)l * 8 + b) * 3072 + cgp * 64 + cc] = s + ada_b[l * 3072 + cgp * 64 + cc]; }
            __syncthreads();
        }
    }
    {
        LAS float* scr = (LAS float*)(L + 49152 + wid * 8448);
        const int gw = blockIdx.x * 8 + wid, NGW = gridDim.x * 8;
        constexpr int I_IN = 4 * 96 * 2 * 16, I_AB = 2 * 4 * 8 * 32, I_O = 4 * 16 * 32, I_1 = 8 * 32 * 4, I_2 = 8 * 2 * 2;
        for (int it = gw; it < I_IN + I_AB + I_O + I_1 + I_2; it += NGW) {
            int r = it;
            if (r < I_IN) {
                const int l = r / 3072; r %= 3072; const int H = r >> 5, hh = (r >> 4) & 1, kb = r & 15;
                int srcb, nv = 32;
                if (H < 60) srcb = 64 * H; else if (H < 76) srcb = 3864 + 64 * (H - 60); else if (H < 92) srcb = 4888 + 64 * (H - 76); else { srcb = 3840; nv = (H == 92 && hh == 0) ? 24 : 0; }
                transpose_item(a.in[5] + (size_t)l * 1024 * NIN, NIN, srcb + 32 * hh, nv, (bf16_t*)(ws + WS_WINT) + (size_t)l * NINP * 1024, 1024, 64 * kb, 256 * (H >> 2) + 128 * hh + 32 * (H & 3), scr, lane);
                continue;
            }
            r -= I_IN;
            if (r < I_AB) {
                const int which = r / 1024; r %= 1024; const int l = r / 256; r %= 256; const int kb = r / 32, nb = r % 32;
                transpose_item(a.in[which ? 17 : 16] + (size_t)l * 512 * 1024, 1024, 32 * nb, 32, (bf16_t*)(ws + (which ? WS_WBT : WS_WAT)) + (size_t)l * 1024 * 512, 512, 64 * kb, 32 * nb, scr, lane);
                continue;
            }
            r -= I_AB;
            if (r < I_O) {
                const int l = r / 512; r %= 512; const int kb = r / 32, nb = r % 32;
                transpose_item(a.in[18] + (size_t)l * 1024 * 1024, 1024, 32 * nb, 32, (bf16_t*)(ws + WS_WOT) + (size_t)l * 1024 * 1024, 1024, 64 * kb, 32 * nb, scr, lane);
                continue;
            }
            r -= I_O;
            if (r < I_1) {
                const int lk = r / 128; r %= 128; const int kb = r / 4, nb = r % 4; const int l = lk >> 1, kv = lk & 1;
                transpose_item(a.in[kv ? 14 : 11] + (size_t)l * 2048 * 128, 128, 32 * nb, 32, (bf16_t*)(ws + WS_W1T) + (size_t)lk * 128 * 2048, 2048, 64 * kb, 32 * nb, scr, lane);
                continue;
            }
            r -= I_1;
            { const int lk = r / 4; r %= 4; const int kb = r / 2, nb = r % 2; const int l = lk >> 1, kv = lk & 1;
              transpose_item(a.in[kv ? 15 : 12] + (size_t)l * 128 * 64, 64, 32 * nb, 32, (bf16_t*)(ws + WS_W2T) + (size_t)lk * 64 * 128, 128, 64 * kb, 32 * nb, scr, lane); }
        }
    }
    {
        f32x2* rope = (f32x2*)(ws + WS_ROPE);
        for (int e = blockIdx.x * 512 + tid; e < 2048 * 32; e += gridDim.x * 512) {
            const int t = e >> 5, i = e & 31;
            double fr = 1.0; for (int k = 0; k < i; ++k) fr *= 0.7498942093324559;
            const float freq = (float)fr; const float ang = (float)t * freq;
            const double x = (double)ang; const double kq = __builtin_rint(x * 0.15915494309189535); const double rr = x - kq * 6.283185307179586;
            const double y = 0.5 * rr, y2 = y * y;
            double sp = 2.8114572543455206e-15; sp = sp * y2 - 7.647163731819816e-13; sp = sp * y2 + 1.6059043836821613e-10; sp = sp * y2 - 2.505210838544172e-08; sp = sp * y2 + 2.7557319223985893e-06;
            sp = sp * y2 - 0.0001984126984126984; sp = sp * y2 + 0.008333333333333333; sp = sp * y2 - 0.16666666666666666; sp = sp * y2 + 1.0; const double s = sp * y;
            double cp = 1.5619206968586225e-16; cp = cp * y2 - 4.779477332387385e-14; cp = cp * y2 + 1.1470745597729725e-11; cp = cp * y2 - 2.08767569878681e-09; cp = cp * y2 + 2.755731922398589e-07;
            cp = cp * y2 - 2.48015873015873e-05; cp = cp * y2 + 0.001388888888888889; cp = cp * y2 - 0.041666666666666664; cp = cp * y2 + 0.5; const double c = 1.0 - cp * y2;
            f32x2 o; o.x = (float)(1.0 - 2.0 * s * s); o.y = (float)(2.0 * s * c); rope[e] = o;
        }
    }
}

__device__ __forceinline__ void phase1(const Args& a, unsigned char* ws, const float* xin, int l, int lane, int wid, int bid, int gdim) {
    const float* g = a.in[4] + l * 1024; const float* mod = (const float*)(ws + WS_MOD) + (size_t)l * 8 * 3072; bf16_t* H = (bf16_t*)(ws + WS_H);
    const int gw = bid * 8 + wid, NGW = gdim * 8;
    for (int row = gw; row < MTOK; row += NGW) {
        const f32x4* xr = (const f32x4*)(xin + (size_t)row * 1024) + lane; f32x4 v[4]; float s = 0.f;
#pragma unroll
        for (int j = 0; j < 4; ++j) { v[j] = xr[64 * j]; s += (v[j].x * v[j].x + v[j].y * v[j].y) + (v[j].z * v[j].z + v[j].w * v[j].w); }
        const float rstd = 1.0f / sqrtf(wave_sum(s) * (1.0f / 1024.0f) + RMS_EPS);
        const float* mb = mod + (size_t)(row >> 11) * 3072; u32x2* o8 = (u32x2*)(H + (size_t)row * 1024) + lane;
#pragma unroll
        for (int j = 0; j < 4; ++j) { const int k = 256 * j + 4 * lane; const f32x4 gg = *(const f32x4*)(g + k), sh = *(const f32x4*)(mb + k), scl = *(const f32x4*)(mb + 1024 + k);
            const f32x4 y = (v[j] * rstd) * gg * (scl + 1.0f) + sh; u32x2 w; w.x = pk2(y.x, y.y); w.y = pk2(y.z, y.w); o8[64 * j] = w; }
    }
}

__device__ __forceinline__ bf16_t* hm_base(unsigned char* ws, size_t off, int b, int nh, int head) { return (bf16_t*)(ws + off) + ((size_t)(b * (nh - 1) + head)) * 2048 * 64; }
struct EpiIn {
    static constexpr bool PERM = true, AFTER_DRAIN = false;
    unsigned char* ws; const float* qg; const float* ksg; const float* kwg;
    __device__ __forceinline__ void operator()(const pg8::f32x4 (&acc)[2][2][4][2], const pg8::Unit& u, int wr, int wc, int fr, int fq) const {
        const int H = u.pn * 4 + wc;
        if (H >= 93) return;
        const int b = u.pm >> 3; const int rowb = u.pm * 256 + wr * 64 + fr;
        if (H == 92) {
            float* ng = (float*)(ws + WS_NG);
            if (fq < 3) {
#pragma unroll
                for (int ai = 0; ai < 2; ++ai)
#pragma unroll
                    for (int m = 0; m < 4; ++m) { const int r = rowb + 128 * ai + 16 * m;
#pragma unroll
                        for (int n = 0; n < 2; ++n) { const pg8::f32x4 v = acc[ai][0][m][n]; f32x4 o; o.x = sigmoidf_(v[0]); o.y = sigmoidf_(v[1]); o.z = sigmoidf_(v[2]); o.w = sigmoidf_(v[3]);
                            *(f32x4*)(ng + (size_t)r * 24 + 8 * fq + 4 * n) = o; } }
            }
            return;
        }
        bf16_t* base; int ld = 64, act = 0; const float* g = nullptr;
        if (H < 8) { base = hm_base(ws, WS_SBQ, b, 8, H); act = 3; }
        else if (H < 16) base = hm_base(ws, WS_SBK, b, 8, H - 8);
        else if (H < 24) base = hm_base(ws, WS_SBV, b, 8, H - 16);
        else if (H < 32) { base = (bf16_t*)(ws + WS_SBZ) + (H - 24) * 64; ld = 512; act = 1; }
        else if (H < 40) { base = hm_base(ws, WS_NQ, b, 8, H - 32); act = 3; g = qg; }
        else if (H < 42) base = hm_base(ws, WS_KCR, b, 2, H - 40);
        else if (H < 44) base = hm_base(ws, WS_VCR, b, 2, H - 42);
        else if (H < 46) { base = hm_base(ws, WS_KS, b, 2, H - 44); g = ksg; }
        else if (H < 48) base = hm_base(ws, WS_VS, b, 2, H - 46);
        else if (H < 50) { base = hm_base(ws, WS_KW, b, 2, H - 48); g = kwg; }
        else if (H < 52) base = hm_base(ws, WS_VW, b, 2, H - 50);
        else if (H < 60) { base = (bf16_t*)(ws + WS_NZ) + (H - 52) * 64; ld = 512; act = 1; }
        else if (H < 76) { base = (bf16_t*)(ws + WS_MA) + (H - 60) * 64; ld = 1024; act = 2; }
        else { base = (bf16_t*)(ws + WS_MB) + (H - 76) * 64; ld = 1024; act = 2; }
        const f32x2* rope = (const f32x2*)(ws + WS_ROPE);
#pragma unroll
        for (int ai = 0; ai < 2; ++ai)
#pragma unroll
            for (int m = 0; m < 4; ++m) {
                const int r = rowb + 128 * ai + 16 * m;
                float v[16];
#pragma unroll
                for (int bj = 0; bj < 2; ++bj)
#pragma unroll
                    for (int n = 0; n < 2; ++n)
#pragma unroll
                        for (int j = 0; j < 4; ++j) v[bj * 8 + n * 4 + j] = acc[ai][bj][m][n][j];
                if (g) {
                    float ss = 0.f;
#pragma unroll
                    for (int i = 0; i < 16; ++i) ss += v[i] * v[i];
                    ss += __shfl_xor(ss, 16); ss += __shfl_xor(ss, 32);
                    const float rstd = 1.0f / sqrtf(ss * (1.0f / 64.0f) + RMS_EPS);
                    const f32x2* rp = rope + (size_t)(r & 2047) * 32 + 8 * fq;
#pragma unroll
                    for (int i = 0; i < 8; ++i) { const float x1 = v[i] * rstd * g[8 * fq + i], x2 = v[8 + i] * rstd * g[32 + 8 * fq + i]; const f32x2 cs = rp[i];
                        v[i] = x1 * cs.x - x2 * cs.y; v[8 + i] = x2 * cs.x + x1 * cs.y; }
                }
                if (act == 1) {
#pragma unroll
                    for (int i = 0; i < 16; ++i) v[i] = siluf_(v[i]);
                } else if (act == 2) {
#pragma unroll
                    for (int i = 0; i < 16; ++i) v[i] = sigmoidf_(v[i]);
                } else if (act == 3) {
#pragma unroll
                    for (int i = 0; i < 16; ++i) v[i] *= 0.125f;
                }
                bf16_t* rowp = base + (size_t)r * ld + 8 * fq;
                u32x4 w0, w1; w0.x = pk2(v[0], v[1]); w0.y = pk2(v[2], v[3]); w0.z = pk2(v[4], v[5]); w0.w = pk2(v[6], v[7]);
                w1.x = pk2(v[8], v[9]); w1.y = pk2(v[10], v[11]); w1.z = pk2(v[12], v[13]); w1.w = pk2(v[14], v[15]);
                *(u32x4*)rowp = w0; *(u32x4*)(rowp + 32) = w1;
            }
    }
};
template <int MODE  > struct EpiOut {
    static constexpr bool PERM = false, AFTER_DRAIN = false;
    unsigned char* ws; const float* xin; float* out; const float* gate;
    __device__ __forceinline__ void operator()(const pg8::f32x4 (&acc)[2][2][4][2], const pg8::Unit& u, int wr, int wc, int fr, int fq) const {
        const int rowb = u.pm * 256 + wr * 64 + fr, colb = u.pn * 256 + wc * 32 + 4 * fq; const int b = u.pm >> 3;
#pragma unroll
        for (int ai = 0; ai < 2; ++ai)
#pragma unroll
            for (int m = 0; m < 4; ++m) { const size_t r = rowb + 128 * ai + 16 * m;
#pragma unroll
                for (int bj = 0; bj < 2; ++bj)
#pragma unroll
                    for (int n = 0; n < 2; ++n) { const int c = colb + 128 * bj + 16 * n; const pg8::f32x4 v = acc[ai][bj][m][n];
                        if (MODE == 0) { const u32x2 mw = *(const u32x2*)((const bf16_t*)(ws + WS_MA) + r * 1024 + c);
                            f32x4 o; o.x = v[0] * bf_lo(mw.x); o.y = v[1] * bf_hi(mw.x); o.z = v[2] * bf_lo(mw.y); o.w = v[3] * bf_hi(mw.y); *(f32x4*)((float*)(ws + WS_YA) + r * 1024 + c) = o; }
                        else if (MODE == 1) { const u32x2 mw = *(const u32x2*)((const bf16_t*)(ws + WS_MB) + r * 1024 + c); const f32x4 ya = *(const f32x4*)((const float*)(ws + WS_YA) + r * 1024 + c);
                            u32x2 o; o.x = pk2(ya.x + v[0] * bf_lo(mw.x), ya.y + v[1] * bf_hi(mw.x)); o.y = pk2(ya.z + v[2] * bf_lo(mw.y), ya.w + v[3] * bf_hi(mw.y)); *(u32x2*)((bf16_t*)(ws + WS_Y) + r * 1024 + c) = o; }
                        else { const f32x4 xv = *(const f32x4*)(xin + r * 1024 + c), gv = *(const f32x4*)(gate + (size_t)b * 3072 + c);
                            f32x4 o; o.x = xv.x + gv.x * v[0]; o.y = xv.y + gv.y * v[1]; o.z = xv.z + gv.z * v[2]; o.w = xv.w + gv.w * v[3]; *(f32x4*)(out + r * 1024 + c) = o; } }
            }
    }
};

constexpr int TROW = 144, TILEB = 64 * TROW;
__device__ __forceinline__ int kvl_of(int v, int r, int hi) { return 32 * v + 8 * (r >> 2) + 4 * hi + (r & 3); }
__device__ __forceinline__ constexpr int kvc(int v, int r) { return 32 * v + 8 * (r >> 2) + (r & 3); }
__device__ __forceinline__ void qk_tile(f32x16& p0, f32x16& p1, const LAS unsigned char* K, const bf16x8 (&qf)[4], int r32, int hi) {
    const LAS unsigned char* kb = K + r32 * TROW + hi * 16;
    f32x16 z = {0.f, 0.f, 0.f, 0.f, 0.f, 0.f, 0.f, 0.f, 0.f, 0.f, 0.f, 0.f, 0.f, 0.f, 0.f, 0.f};
    p0 = z; p1 = z;
#pragma unroll
    for (int d0 = 0; d0 < 4; ++d0) {
        const bf16x8 a0 = *(const LAS bf16x8*)(kb + d0 * 32), a1 = *(const LAS bf16x8*)(kb + 32 * TROW + d0 * 32);
        p0 = __builtin_amdgcn_mfma_f32_32x32x16_bf16(a0, qf[d0], p0, 0, 0, 0);
        p1 = __builtin_amdgcn_mfma_f32_32x32x16_bf16(a1, qf[d0], p1, 0, 0, 0);
    }
}
__device__ __forceinline__ s16x4 vtr(const LAS unsigned char* p) { return __builtin_bit_cast(s16x4, __builtin_amdgcn_ds_read_tr16_b64_v4i16((LAS s16x4*)p)); }
__device__ __forceinline__ void pv_tile(f32x16 (&o)[2], const LAS unsigned char* V, const f32x16& e0, const f32x16& e1, int lane) {
    const int hi = lane >> 5;
    const LAS unsigned char* vb = V + (4 * hi + ((lane & 15) >> 2)) * TROW + (16 * ((lane >> 4) & 1) + 4 * (lane & 3)) * 2;
#pragma unroll
    for (int ks = 0; ks < 4; ++ks) {
        u32x4 pw;
        if (ks == 0) { pw.x = pk2(e0[0], e0[1]); pw.y = pk2(e0[2], e0[3]); pw.z = pk2(e0[4], e0[5]); pw.w = pk2(e0[6], e0[7]); }
        else if (ks == 1) { pw.x = pk2(e0[8], e0[9]); pw.y = pk2(e0[10], e0[11]); pw.z = pk2(e0[12], e0[13]); pw.w = pk2(e0[14], e0[15]); }
        else if (ks == 2) { pw.x = pk2(e1[0], e1[1]); pw.y = pk2(e1[2], e1[3]); pw.z = pk2(e1[4], e1[5]); pw.w = pk2(e1[6], e1[7]); }
        else { pw.x = pk2(e1[8], e1[9]); pw.y = pk2(e1[10], e1[11]); pw.z = pk2(e1[12], e1[13]); pw.w = pk2(e1[14], e1[15]); }
        const bf16x8 pb = __builtin_bit_cast(bf16x8, pw);
#pragma unroll
        for (int dt = 0; dt < 2; ++dt) {
            const s16x4 lo = vtr(vb + ks * 16 * TROW + dt * 64), hh = vtr(vb + (ks * 16 + 8) * TROW + dt * 64);
            const bf16x8 va = {lo[0], lo[1], lo[2], lo[3], hh[0], hh[1], hh[2], hh[3]};
            o[dt] = __builtin_amdgcn_mfma_f32_32x32x16_bf16(va, pb, o[dt], 0, 0, 0);
        }
    }
}
#define F16ZERO (f32x16){0.f, 0.f, 0.f, 0.f, 0.f, 0.f, 0.f, 0.f, 0.f, 0.f, 0.f, 0.f, 0.f, 0.f, 0.f, 0.f}

__device__ __forceinline__ void sb_unit(unsigned char* ws, LAS unsigned char* L, int b, int h, int qb, int tid, int lane, int wid) {
    const int r32 = lane & 31, hi = lane >> 5;
    const int tw0 = qb * 256 + 32 * wid, t = tw0 + r32;
    const bf16_t* Qp = (const bf16_t*)(ws + WS_SBQ) + ((size_t)(b * 8 + h) * 2048) * 64;
    const bf16_t* Kp = (const bf16_t*)(ws + WS_SBK) + ((size_t)(b * 8 + h) * 2048) * 64;
    const bf16_t* Vp = (const bf16_t*)(ws + WS_SBV) + ((size_t)(b * 8 + h) * 2048) * 64;
    bf16x8 qf[4];
#pragma unroll
    for (int d0 = 0; d0 < 4; ++d0) qf[d0] = *(const bf16x8*)(Qp + (size_t)t * 64 + 16 * d0 + 8 * hi);
    const int goff = (tid >> 3) * 64 + (tid & 7) * 8, loff = (tid >> 3) * TROW + (tid & 7) * 16;
    f32x16 o[2]; o[0] = F16ZERO; o[1] = F16ZERO;
    float carry = 0.f;
    const int jt0 = 4 * qb + 3;
    u32x4 rk = *(const u32x4*)(Kp + (size_t)jt0 * 4096 + goff), rv = *(const u32x4*)(Vp + (size_t)jt0 * 4096 + goff);
    __syncthreads();
    *(LAS u32x4*)(L + loff) = rk; *(LAS u32x4*)(L + 2 * TILEB + loff) = rv;
    __syncthreads();
    int cur = 0;
    for (int jt = jt0; jt >= 0; --jt) {
        if (jt > 0) { rk = *(const u32x4*)(Kp + (size_t)(jt - 1) * 4096 + goff); rv = *(const u32x4*)(Vp + (size_t)(jt - 1) * 4096 + goff); }
        const int kb = 64 * jt;
        if (kb <= tw0) {
            const LAS unsigned char* Kt = L + cur * TILEB; const LAS unsigned char* Vt = L + (2 + cur) * TILEB;
            f32x16 p0, p1; qk_tile(p0, p1, Kt, qf, r32, hi);
            f32x16 lk0, lk1; const int lim = t - kb - 4 * hi;
#pragma unroll
            for (int r = 0; r < 16; ++r) {
                { const float z = p0[r]; const float sp = fmaxf(z, 0.f) + __logf(1.0f + __expf(-fabsf(z))); const bool st = kvc(0, r) < lim; lk0[r] = st ? -sp : 0.f; p0[r] = st ? (z - sp) : NEGF; }
                { const float z = p1[r]; const float sp = fmaxf(z, 0.f) + __logf(1.0f + __expf(-fabsf(z))); const bool st = kvc(1, r) < lim; lk1[r] = st ? -sp : 0.f; p1[r] = st ? (z - sp) : NEGF; }
            }
            float T[8], Tp[8], U[8], R[8];
#pragma unroll
            for (int c = 0; c < 8; ++c) {
                float x0, x1, x2, x3;
                if (c < 4) { x0 = lk0[4 * c]; x1 = lk0[4 * c + 1]; x2 = lk0[4 * c + 2]; x3 = lk0[4 * c + 3]; } else { x0 = lk1[4 * c - 16]; x1 = lk1[4 * c - 15]; x2 = lk1[4 * c - 14]; x3 = lk1[4 * c - 13]; }
                const float s2 = x3, s1 = x3 + x2, s0 = s1 + x1; T[c] = s0 + x0;
                if (c < 4) { lk0[4 * c] = s0; lk0[4 * c + 1] = s1; lk0[4 * c + 2] = s2; lk0[4 * c + 3] = 0.f; } else { lk1[4 * c - 16] = s0; lk1[4 * c - 15] = s1; lk1[4 * c - 14] = s2; lk1[4 * c - 13] = 0.f; }
            }
#pragma unroll
            for (int c = 0; c < 8; ++c) { Tp[c] = __shfl_xor(T[c], 32); U[c] = T[c] + Tp[c]; }
            R[7] = 0.f;
#pragma unroll
            for (int c = 6; c >= 0; --c) R[c] = R[c + 1] + U[c + 1];
#pragma unroll
            for (int c = 0; c < 8; ++c) {
                const float off = R[c] + (hi == 0 ? Tp[c] : 0.f) + carry;
#pragma unroll
                for (int i = 0; i < 4; ++i) {
                    if (c < 4) p0[4 * c + i] = __expf(p0[4 * c + i] + lk0[4 * c + i] + off);
                    else p1[4 * c - 16 + i] = __expf(p1[4 * c - 16 + i] + lk1[4 * c - 16 + i] + off);
                }
            }
            carry += R[0] + U[0];
            pv_tile(o, Vt, p0, p1, lane);
        }
        if (jt > 0) { *(LAS u32x4*)(L + (cur ^ 1) * TILEB + loff) = rk; *(LAS u32x4*)(L + (2 + (cur ^ 1)) * TILEB + loff) = rv; }
        __syncthreads();
        cur ^= 1;
    }
    const size_t tok = (size_t)b * 2048 + t;
    const bf16_t* zrow = (const bf16_t*)(ws + WS_SBZ) + tok * 512 + h * 64; bf16_t* arow = (bf16_t*)(ws + WS_AACT) + tok * 512 + h * 64;
#pragma unroll
    for (int dt = 0; dt < 2; ++dt)
#pragma unroll
        for (int c4 = 0; c4 < 4; ++c4) { const int d = 32 * dt + 8 * c4 + 4 * hi; const u32x2 zw = *(const u32x2*)(zrow + d);
            u32x2 w; w.x = pk2(o[dt][4 * c4] * bf_lo(zw.x), o[dt][4 * c4 + 1] * bf_hi(zw.x)); w.y = pk2(o[dt][4 * c4 + 2] * bf_lo(zw.y), o[dt][4 * c4 + 3] * bf_hi(zw.y)); *(u32x2*)(arow + d) = w; }
}

__device__ __forceinline__ void cmp_unit(const Args& a, unsigned char* ws, LAS unsigned char* L, int l, int u, int tid, int lane, int wid) {
    const int nt = u & 3, g = (u >> 2) & 1, b = (u >> 3) & 7, kv = u >> 6;
    const int r32 = lane & 31, hi = lane >> 5;
    const bf16_t* src = (const bf16_t*)(ws + (kv ? WS_VCR : WS_KCR)) + ((size_t)(b * 2 + g) * 2048) * 64;
    const bf16_t* W1T = (const bf16_t*)(ws + WS_W1T) + (size_t)(l * 2 + kv) * 128 * 2048;
    const bf16_t* W2T = (const bf16_t*)(ws + WS_W2T) + (size_t)(l * 2 + kv) * 64 * 128;
    const float* pe = a.in[kv ? 13 : 10] + (size_t)l * 2048;
    LAS float* red = (LAS float*)L; LAS bf16_t* hid = (LAS bf16_t*)(L + 32768); LAS float* kraw = (LAS float*)(L + 41472);
    const int j = wid & 3, kh = wid >> 2;
    f32x16 acc = F16ZERO;
    const bf16_t* ap = src + (size_t)(32 * nt + r32) * 1024 + kh * 1024 + 8 * hi; const bf16_t* bp = W1T + (size_t)(32 * j + r32) * 2048 + kh * 1024 + 8 * hi; const float* pp = pe + kh * 1024 + 8 * hi;
#pragma unroll 4
    for (int kk = 0; kk < 64; ++kk) {
        const u32x4 aw = *(const u32x4*)(ap + 16 * kk); const bf16x8 bw = *(const bf16x8*)(bp + 16 * kk); const f32x4 pa = *(const f32x4*)(pp + 16 * kk), pb = *(const f32x4*)(pp + 16 * kk + 4);
        u32x4 w; w.x = pk2(bf_lo(aw.x) + pa.x, bf_hi(aw.x) + pa.y); w.y = pk2(bf_lo(aw.y) + pa.z, bf_hi(aw.y) + pa.w); w.z = pk2(bf_lo(aw.z) + pb.x, bf_hi(aw.z) + pb.y); w.w = pk2(bf_lo(aw.w) + pb.z, bf_hi(aw.w) + pb.w);
        acc = __builtin_amdgcn_mfma_f32_32x32x16_bf16(__builtin_bit_cast(bf16x8, w), bw, acc, 0, 0, 0);
    }
    __syncthreads();
#pragma unroll
    for (int r = 0; r < 16; ++r) red[((kh * 4 + j) * 32 + kvl_of(0, r, hi)) * 32 + r32] = acc[r];
    __syncthreads();
    for (int e = tid; e < 32 * 128; e += 512) { const int row = e >> 7, col = e & 127; const float v = red[((col >> 5) * 32 + row) * 32 + (col & 31)] + red[((4 + (col >> 5)) * 32 + row) * 32 + (col & 31)];
        hid[row * 136 + col] = (bf16_t)f2bf(siluf_(v)); }
    __syncthreads();
    if (wid < 2) {
        f32x16 o2 = F16ZERO;
#pragma unroll
        for (int ks = 0; ks < 8; ++ks) { const bf16x8 af = *(const LAS bf16x8*)(hid + r32 * 136 + 16 * ks + 8 * hi); const bf16x8 bf = *(const bf16x8*)(W2T + (size_t)(32 * wid + r32) * 128 + 16 * ks + 8 * hi);
            o2 = __builtin_amdgcn_mfma_f32_32x32x16_bf16(af, bf, o2, 0, 0, 0); }
#pragma unroll
        for (int r = 0; r < 16; ++r) kraw[kvl_of(0, r, hi) * 65 + 32 * wid + r32] = o2[r];
    }
    __syncthreads();
    {
        const int row = tid >> 4, dl = tid & 15, n = 32 * nt + row;
        float x[4]; x[0] = kraw[row * 65 + dl]; x[1] = kraw[row * 65 + dl + 16]; x[2] = kraw[row * 65 + dl + 32]; x[3] = kraw[row * 65 + dl + 48];
        bf16_t* dst = (bf16_t*)(ws + (kv ? WS_VC : WS_KC)) + ((size_t)(b * 2 + g) * 128 + n) * 64;
        if (kv == 0) {
            float ss = x[0] * x[0] + x[1] * x[1] + x[2] * x[2] + x[3] * x[3];
            ss += __shfl_xor(ss, 1); ss += __shfl_xor(ss, 2); ss += __shfl_xor(ss, 4); ss += __shfl_xor(ss, 8);
            const float rstd = 1.0f / sqrtf(ss * (1.0f / 64.0f) + RMS_EPS); const float* gk = a.in[7] + l * 64;
            const int pos = (n < 127) ? 16 * n + 31 : 2047; const f32x2* rp = (const f32x2*)(ws + WS_ROPE) + (size_t)pos * 32;
#pragma unroll
            for (int q = 0; q < 2; ++q) { const int i = dl + 16 * q; const float x1 = x[q] * rstd * gk[i], x2 = x[2 + q] * rstd * gk[i + 32]; const f32x2 cs = rp[i];
                x[q] = x1 * cs.x - x2 * cs.y; x[2 + q] = x2 * cs.x + x1 * cs.y; }
        }
        if (n == 127) { x[0] = 0.f; x[1] = 0.f; x[2] = 0.f; x[3] = 0.f; }
        dst[dl] = (bf16_t)f2bf(x[0]); dst[dl + 16] = (bf16_t)f2bf(x[1]); dst[dl + 32] = (bf16_t)f2bf(x[2]); dst[dl + 48] = (bf16_t)f2bf(x[3]);
    }
}

__device__ __forceinline__ void softmax_step(f32x16& p0, f32x16& p1, float& m, float& lsum, f32x16 (&o)[2], int kb, int t, int mode, bool sel, int hi) {
    if (mode != 0 || !sel) {
        int lo = -1000000, hi_ = 1000000;
        if (mode == 1) hi_ = t - kb - 4 * hi; else if (mode == 2) lo = t - 255 - kb - 4 * hi;
        if (!sel) hi_ = -2000000;
#pragma unroll
        for (int r = 0; r < 16; ++r) {
            p0[r] = (kvc(0, r) >= lo && kvc(0, r) <= hi_) ? p0[r] : NEGF; p1[r] = (kvc(1, r) >= lo && kvc(1, r) <= hi_) ? p1[r] : NEGF;
        }
    }
    float rm = fmaxf(p0[0], p1[0]);
#pragma unroll
    for (int r = 1; r < 16; ++r) rm = fmaxf(rm, fmaxf(p0[r], p1[r]));
    rm = fmaxf(rm, __shfl_xor(rm, 32));
    const float mn = fmaxf(m, rm), alpha = __expf(m - mn);
    float ls = 0.f;
#pragma unroll
    for (int r = 0; r < 16; ++r) { p0[r] = __expf(p0[r] - mn); p1[r] = __expf(p1[r] - mn); ls += p0[r] + p1[r]; }
    lsum = lsum * alpha + ls; m = mn;
#pragma unroll
    for (int r = 0; r < 16; ++r) { o[0][r] *= alpha; o[1][r] *= alpha; }
}

__device__ __forceinline__ void nsa_unit(unsigned char* ws, LAS unsigned char* L, int b, int g, int cur, int tid, int lane, int wid) {
    const int r32 = lane & 31, hi = lane >> 5, hh = wid >> 1, qh = wid & 1, h = 4 * g + hh;
    const int ql = 32 * qh + r32, t = 64 * cur + ql; const size_t tok = (size_t)b * 2048 + t;
    const bf16_t* Qp = (const bf16_t*)(ws + WS_NQ) + ((size_t)(b * 8 + h) * 2048 + t) * 64;
    bf16x8 qf[4];
#pragma unroll
    for (int d0 = 0; d0 < 4; ++d0) qf[d0] = *(const bf16x8*)(Qp + 16 * d0 + 8 * hi);
    const bf16_t* KCp = (const bf16_t*)(ws + WS_KC) + (size_t)(b * 2 + g) * 128 * 64; const bf16_t* VCp = (const bf16_t*)(ws + WS_VC) + (size_t)(b * 2 + g) * 128 * 64;
    const size_t kvo = (size_t)(b * 2 + g) * 2048 * 64;
    const bf16_t* KSp = (const bf16_t*)(ws + WS_KS) + kvo; const bf16_t* VSp = (const bf16_t*)(ws + WS_VS) + kvo;
    const bf16_t* KWp = (const bf16_t*)(ws + WS_KW) + kvo; const bf16_t* VWp = (const bf16_t*)(ws + WS_VW) + kvo;
    LAS float* IMP = (LAS float*)(L + 4 * TILEB); LAS unsigned* SEL = (LAS unsigned*)(L + 4 * TILEB + 4 * 64 * 33 * 4);
    const int goff = (tid >> 3) * 64 + (tid & 7) * 8, loff = (tid >> 3) * TROW + (tid & 7) * 16;
    const float* ngp = (const float*)(ws + WS_NG) + tok * 24 + h;
    f32x16 res[2];
    {
        const u32x4 rk0 = *(const u32x4*)(KCp + goff), rk1 = *(const u32x4*)(KCp + 4096 + goff), rv0 = *(const u32x4*)(VCp + goff), rv1 = *(const u32x4*)(VCp + 4096 + goff);
        __syncthreads();
        *(LAS u32x4*)(L + loff) = rk0; *(LAS u32x4*)(L + TILEB + loff) = rk1; *(LAS u32x4*)(L + 2 * TILEB + loff) = rv0; *(LAS u32x4*)(L + 3 * TILEB + loff) = rv1;
        __syncthreads();
        f32x16 p0, p1, p2, p3; qk_tile(p0, p1, L, qf, r32, hi); qk_tile(p2, p3, L + TILEB, qf, r32, hi);
        float mx = NEGF;
        const int thr = ((t - 31) >> 4) - 4 * hi;
#pragma unroll
        for (int r = 0; r < 16; ++r) {
            p0[r] = (kvc(0, r) <= thr) ? p0[r] : NEGF; p1[r] = (kvc(1, r) <= thr) ? p1[r] : NEGF; p2[r] = (kvc(2, r) <= thr) ? p2[r] : NEGF; p3[r] = (kvc(3, r) <= thr) ? p3[r] : NEGF;
            mx = fmaxf(fmaxf(mx, fmaxf(p0[r], p1[r])), fmaxf(p2[r], p3[r]));
        }
        mx = fmaxf(mx, __shfl_xor(mx, 32));
        float ls = 0.f;
#pragma unroll
        for (int r = 0; r < 16; ++r) {
            p0[r] = (p0[r] > -1e29f) ? __expf(p0[r] - mx) : 0.f; p1[r] = (p1[r] > -1e29f) ? __expf(p1[r] - mx) : 0.f;
            p2[r] = (p2[r] > -1e29f) ? __expf(p2[r] - mx) : 0.f; p3[r] = (p3[r] > -1e29f) ? __expf(p3[r] - mx) : 0.f;
            ls += (p0[r] + p1[r]) + (p2[r] + p3[r]);
        }
        ls += __shfl_xor(ls, 32);
        const float inv = ls > 0.f ? 1.0f / ls : 0.f;
#pragma unroll
        for (int r = 0; r < 16; ++r) { p0[r] *= inv; p1[r] *= inv; p2[r] *= inv; p3[r] *= inv; }
        float gs[16], tl[16], tlp[16];
#pragma unroll
        for (int c = 0; c < 4; ++c) {
            gs[c] = (p0[4 * c] + p0[4 * c + 1]) + (p0[4 * c + 2] + p0[4 * c + 3]); tl[c] = p0[4 * c + 3];
            gs[4 + c] = (p1[4 * c] + p1[4 * c + 1]) + (p1[4 * c + 2] + p1[4 * c + 3]); tl[4 + c] = p1[4 * c + 3];
            gs[8 + c] = (p2[4 * c] + p2[4 * c + 1]) + (p2[4 * c + 2] + p2[4 * c + 3]); tl[8 + c] = p2[4 * c + 3];
            gs[12 + c] = (p3[4 * c] + p3[4 * c + 1]) + (p3[4 * c + 2] + p3[4 * c + 3]); tl[12 + c] = p3[4 * c + 3];
        }
#pragma unroll
        for (int c = 0; c < 16; ++c) tlp[c] = __shfl_xor(tl[c], 32);
        LAS float* impr = IMP + (hh * 64 + ql) * 33;
#pragma unroll
        for (int c = 0; c < 16; ++c) {
            const float prev0 = (c > 0) ? tlp[c - 1] : 0.f;
            impr[2 * c + hi] = gs[c] + (hi ? tlp[c] : prev0);
        }
        f32x16 o[2]; o[0] = F16ZERO; o[1] = F16ZERO;
        pv_tile(o, L + 2 * TILEB, p0, p1, lane); pv_tile(o, L + 3 * TILEB, p2, p3, lane);
        const float g0 = ngp[0];
#pragma unroll
        for (int r = 0; r < 16; ++r) { res[0][r] = o[0][r] * g0; res[1][r] = o[1][r] * g0; }
        __syncthreads();
        if (wid == 0) {
            float v[32];
#pragma unroll
            for (int j = 0; j < 32; ++j) v[j] = ((IMP[(0 * 64 + lane) * 33 + j] + IMP[(1 * 64 + lane) * 33 + j]) + IMP[(2 * 64 + lane) * 33 + j]) + IMP[(3 * 64 + lane) * 33 + j];
            unsigned mask;
            if (cur <= 7) mask = (2u << cur) - 1u;
            else {
                mask = 1u | (1u << (cur - 1)) | (1u << cur);
#pragma unroll
                for (int j = 1; j < 30; ++j) if (j > cur - 2) v[j] = -1.0f;
                for (int pick = 0; pick < 5; ++pick) {
                    float best = -0.5f; int bi = 1;
#pragma unroll
                    for (int j = 1; j < 30; ++j) { if (v[j] > best) { best = v[j]; bi = j; } }
                    mask |= 1u << bi;
#pragma unroll
                    for (int j = 1; j < 30; ++j) if (j == bi) v[j] = -1.0f;
                }
            }
            SEL[lane] = mask;
        }
        __syncthreads();
    }
    const unsigned selm = SEL[ql];
    const int n_slc = cur + 1, n_win = (cur + 1 < 5) ? cur + 1 : 5, total = n_slc + n_win;
    u32x4 rk = *(const u32x4*)(KSp + (size_t)cur * 4096 + goff), rv = *(const u32x4*)(VSp + (size_t)cur * 4096 + goff);
    *(LAS u32x4*)(L + loff) = rk; *(LAS u32x4*)(L + 2 * TILEB + loff) = rv;
    __syncthreads();
    float m = NEGF, lsum = 0.f; f32x16 o[2]; o[0] = F16ZERO; o[1] = F16ZERO;
    int cb = 0;
    for (int i = 0; i < total; ++i) {
        if (i + 1 < total) {
            const int i2 = i + 1; const bool w2 = i2 >= n_slc; const int j2 = w2 ? cur - (i2 - n_slc) : cur - i2;
            rk = *(const u32x4*)((w2 ? KWp : KSp) + (size_t)j2 * 4096 + goff); rv = *(const u32x4*)((w2 ? VWp : VSp) + (size_t)j2 * 4096 + goff);
        }
        const bool isw = i >= n_slc; const int j = isw ? cur - (i - n_slc) : cur - i;
        int mode = 0; bool sel = true;
        if (j == cur) mode = 1; else if (isw && j == cur - 4) mode = 2;
        if (!isw) sel = (selm >> j) & 1u;
        {
            f32x16 p0, p1; qk_tile(p0, p1, L + cb * TILEB, qf, r32, hi);
            softmax_step(p0, p1, m, lsum, o, 64 * j, t, mode, sel, hi);
            pv_tile(o, L + (2 + cb) * TILEB, p0, p1, lane);
        }
        if (i == n_slc - 1 || i == total - 1) {
            const float lt = lsum + __shfl_xor(lsum, 32); const float gg = ngp[isw ? 16 : 8] / lt;
#pragma unroll
            for (int r = 0; r < 16; ++r) { res[0][r] += o[0][r] * gg; res[1][r] += o[1][r] * gg; }
            m = NEGF; lsum = 0.f; o[0] = F16ZERO; o[1] = F16ZERO;
        }
        if (i + 1 < total) { *(LAS u32x4*)(L + (cb ^ 1) * TILEB + loff) = rk; *(LAS u32x4*)(L + (2 + (cb ^ 1)) * TILEB + loff) = rv; }
        __syncthreads();
        cb ^= 1;
    }
    const bf16_t* zrow = (const bf16_t*)(ws + WS_NZ) + tok * 512 + h * 64; bf16_t* brow = (bf16_t*)(ws + WS_BACT) + tok * 512 + h * 64;
#pragma unroll
    for (int dt = 0; dt < 2; ++dt)
#pragma unroll
        for (int c4 = 0; c4 < 4; ++c4) { const int d = 32 * dt + 8 * c4 + 4 * hi; const u32x2 zw = *(const u32x2*)(zrow + d);
            u32x2 w; w.x = pk2(res[dt][4 * c4] * bf_lo(zw.x), res[dt][4 * c4 + 1] * bf_hi(zw.x)); w.y = pk2(res[dt][4 * c4 + 2] * bf_lo(zw.y), res[dt][4 * c4 + 3] * bf_hi(zw.y)); *(u32x2*)(brow + d) = w; }
}

__global__ void __launch_bounds__(512, 2) mega_fwd(Args a) {
    extern __shared__ __attribute__((aligned(16))) unsigned char lds_raw[];
    LAS unsigned char* L = (LAS unsigned char*)lds_raw;
    cg::grid_group grid = cg::this_grid();
    int ph = a.ph_lo;
    const int wid0 = __builtin_amdgcn_readfirstlane(threadIdx.x >> 6);
    if (ph == 0) {
        const int tid = threadIdx.x, lane = tid & 63, wid = __builtin_amdgcn_readfirstlane(tid >> 6);
        phase0(a, a.ws, L, tid, lane, wid);
        ++ph;
        if (ph < a.ph_hi) grid.sync();
    }
    for (; ph < a.ph_hi; ++ph) {
        unsigned char* ws = a.ws; asm volatile("" : "+s"(ws));
        int lane_l = __builtin_amdgcn_mbcnt_hi(~0u, __builtin_amdgcn_mbcnt_lo(~0u, 0u)), wid_l = wid0; asm volatile("" : "+v"(lane_l), "+s"(wid_l));
        const int lane = lane_l, wid = wid_l, tid = wid * 64 + lane;
        int bid = blockIdx.x, gdim = gridDim.x; asm volatile("" : "+s"(bid), "+s"(gdim));
        {
            const int l = (ph - 1) / 6, k = (ph - 1) % 6;
            const float* xin = (l == 0) ? a.in[0] : a.out;
            if (k == 0) phase1(a, ws, xin, l, lane, wid, bid, gdim);
            else if (k == 1) {
                pg8::Gemm gm{(const pg8::bf16_t*)(ws + WS_H), (const pg8::bf16_t*)(ws + WS_WINT) + (size_t)l * NINP * 1024, MTOK, NINP, 1024};
                pg8::StaticOrder S; S.init(MTOK, NINP, gdim, bid);
                EpiIn E{ws, a.in[6] + l * 64, a.in[8] + l * 64, a.in[9] + l * 64};
                pg8::gemm_phase<EpiIn, pg8::StaticOrder, true, true>((PG8_LAS unsigned char*)L, gm, S, E, tid);
            } else if (k == 2) {
                if (bid < 128) cmp_unit(a, ws, L, l, bid, tid, lane, wid);
                for (int c = bid; c < 256; c += gdim) {
                    const int bh = c & 63, s = c >> 6;
                    sb_unit(ws, L, bh >> 3, bh & 7, 7 - s, tid, lane, wid);
                    sb_unit(ws, L, bh >> 3, bh & 7, s, tid, lane, wid);
                }
            } else if (k == 3) {
                for (int c = bid; c < 256; c += gdim) {
                    const int bg = c & 15, s = c >> 4;
                    nsa_unit(ws, L, bg >> 1, bg & 1, 31 - s, tid, lane, wid);
                    nsa_unit(ws, L, bg >> 1, bg & 1, s, tid, lane, wid);
                }
            } else if (k == 4) {
                pg8::StaticOrder S; S.init(MTOK, 1024, gdim, bid);
                { pg8::Gemm gm{(const pg8::bf16_t*)(ws + WS_AACT), (const pg8::bf16_t*)(ws + WS_WAT) + (size_t)l * 1024 * 512, MTOK, 1024, 512};
                  EpiOut<0> E{ws, nullptr, nullptr, nullptr}; pg8::gemm_phase<EpiOut<0>, pg8::StaticOrder, true, true>((PG8_LAS unsigned char*)L, gm, S, E, tid); }
                { pg8::Gemm gm{(const pg8::bf16_t*)(ws + WS_BACT), (const pg8::bf16_t*)(ws + WS_WBT) + (size_t)l * 1024 * 512, MTOK, 1024, 512};
                  EpiOut<1> E{ws, nullptr, nullptr, nullptr}; pg8::gemm_phase<EpiOut<1>, pg8::StaticOrder, true, true>((PG8_LAS unsigned char*)L, gm, S, E, tid); }
            } else {
                pg8::StaticOrder S; S.init(MTOK, 1024, gdim, bid);
                pg8::Gemm gm{(const pg8::bf16_t*)(ws + WS_Y), (const pg8::bf16_t*)(ws + WS_WOT) + (size_t)l * 1024 * 1024, MTOK, 1024, 1024};
                EpiOut<2> E{ws, xin, a.out, (const float*)(ws + WS_MOD) + (size_t)l * 8 * 3072 + 2048};
                pg8::gemm_phase<EpiOut<2>, pg8::StaticOrder, true, true>((PG8_LAS unsigned char*)L, gm, S, E, tid);
            }
        }
        if (ph + 1 < a.ph_hi) grid.sync();
    }
}

#ifndef MK_PER_PHASE
#define MK_PER_PHASE 0
#endif
extern "C" void kernel_launch(void* const* d_in, const int* in_sizes, int n_in, void* d_out, int out_size, void* d_ws, size_t ws_size, hipStream_t stream) {
    static int grid = 0;
    if (grid == 0) {
        if (n_in != 19 || out_size != MTOK * DM || ws_size < WS_END) { fprintf(stderr, "kernel_launch: unexpected shapes (n_in %d out %d ws %zu need %zu)\n", n_in, out_size, ws_size, (size_t)WS_END); grid = -1; return; }
        int dev = 0, cus = 0, per_cu = 0;
        hipGetDevice(&dev); hipDeviceGetAttribute(&cus, hipDeviceAttributeMultiprocessorCount, dev);
        if (hipFuncSetAttribute((const void*)mega_fwd, hipFuncAttributeMaxDynamicSharedMemorySize, LDS_BYTES) != hipSuccess) { fprintf(stderr, "kernel_launch: hipFuncSetAttribute failed\n"); grid = -1; return; }
        if (hipOccupancyMaxActiveBlocksPerMultiprocessor(&per_cu, (const void*)mega_fwd, 512, LDS_BYTES) != hipSuccess || per_cu < 1) { fprintf(stderr, "kernel_launch: occupancy query says %d\n", per_cu); per_cu = 1; }
        (void)hipGetLastError();
        grid = cus * 1;
        if (grid > 256) grid = 256;
    }
    if (grid < 0) return;
    Args a{};
    for (int i = 0; i < 19; ++i) a.in[i] = (const float*)d_in[i];
    a.out = (float*)d_out; a.ws = (unsigned char*)d_ws;
#if MK_PER_PHASE
    for (int ph = 0; ph < 25; ++ph) { a.ph_lo = ph; a.ph_hi = ph + 1; hipLaunchKernelGGL(mega_fwd, dim3(grid), dim3(512), LDS_BYTES, stream, a); }
#else
    a.ph_lo = 0; a.ph_hi = 25;
    void* args[] = {&a};
    hipError_t e = hipLaunchCooperativeKernel((const void*)mega_fwd, dim3(grid), dim3(512), args, LDS_BYTES, stream);
    if (e != hipSuccess) fprintf(stderr, "cooperative launch failed: %s (grid %d)\n", hipGetErrorString(e), grid);
#endif
}
```

```cpp
#include <hip/hip_runtime.h>
#include <hip/hip_cooperative_groups.h>
#include <cstdio>
#include <cstdint>
namespace cg = cooperative_groups;
namespace pg8 {
#define PG8_LAS __attribute__((address_space(3)))
typedef unsigned short bf16_t;
typedef short bf16x8 __attribute__((ext_vector_type(8)));
typedef float f32x4 __attribute__((ext_vector_type(4)));
typedef unsigned u32x4 __attribute__((ext_vector_type(4)));
constexpr int BM = 256, BK = 64, HALF = 128, HTB = HALF * BK * 2  , STAGE_BYTES = 8 * HTB, NXCD = 8, WGM = 8;

__host__ __device__ __forceinline__ int lds_byte(int r, int c) { const int st = (r >> 4) * 2 + (c >> 5), rr = r & 15, cc = c & 31, ob = rr * 64 + cc * 2; return st * 1024 + (ob ^ (((ob >> 9) & 1) << 5)); }
__host__ __device__ __forceinline__ void stage_rc(int b, int& R, int& C) { const int st = b / 1024, sb = b % 1024, swz = sb ^ (((sb >> 9) & 1) << 5); R = (st >> 1) * 16 + swz / 64; C = (st & 1) * 32 + (swz % 64) / 2; }
__host__ __device__ __forceinline__ int perm32(int rho) { const int n = rho >> 4, i = rho & 15; return 8 * (i >> 2) + 4 * n + (i & 3); }

struct Unit { int pm, pn; };
struct Gemm { const bf16_t* A; const bf16_t* Bt; int M, N, K; };

struct StaticOrder {
    int nM, nN, nwg, G, c;
    __host__ __device__ void init(int M, int N, int G_, int c_) { nM = M / BM; nN = N / BM; nwg = nM * nN; G = G_; c = c_; }
    __host__ __device__ bool next(int i, Unit& u) const {
        const long L = (long)i * G + c; if (L >= nwg) return false;
        int wgid = (int)L; { const int q = nwg / NXCD, r = nwg % NXCD, xcd = wgid % NXCD, off = wgid / NXCD; wgid = (xcd < r ? xcd * (q + 1) : r * (q + 1) + (xcd - r) * q) + off; }
        const int nig = WGM * nN, gid = wgid / nig, fm = gid * WGM, gsz = (nM - fm) < WGM ? (nM - fm) : WGM;
        u.pm = fm + ((wgid % nig) % gsz); u.pn = (wgid % nig) / gsz; return true;
    }
    __device__ __forceinline__ void a_ready(const Unit&) const {}
    __device__ __forceinline__ void done(const Unit&) const {}
};

__device__ __forceinline__ unsigned cvt_pk_bf16(float lo, float hi) { unsigned r; asm volatile("v_cvt_pk_bf16_f32 %0, %1, %2" : "=v"(r) : "v"(lo), "v"(hi)); return r; }
typedef float f32x2 __attribute__((ext_vector_type(2)));
__device__ __forceinline__ f32x2 gelu_pk(f32x2 v) {
    const f32x2 av = __builtin_elementwise_abs(v), d = av * 0.2316418882f + 1.0f;
    f32x2 t; t.x = __builtin_amdgcn_rcpf(d.x); t.y = __builtin_amdgcn_rcpf(d.y);
    f32x2 q = t * 0.5307027145f + (-0.7265760135f); q = q * t + 0.7107068705f; q = q * t + (-0.142248368f); q = q * t + 0.127414796f; q = q * t;
    const f32x2 s = (v * v) * (-0.72134752044f);
    f32x2 e; e.x = __builtin_amdgcn_exp2f(s.x); e.y = __builtin_amdgcn_exp2f(s.y);
    const f32x2 m = v * (q * e), r = v - m;
    f32x2 o; o.x = v.x < 0.f ? m.x : r.x; o.y = v.y < 0.f ? m.y : r.y; return o;
}

template <int ACT  > struct EpiBf16 {
    static constexpr bool PERM = true, AFTER_DRAIN = false; static_assert(ACT == 0 || ACT == 1, "EpiBf16: ACT is 0 (none) or 1 (gelu_pk)");
    bf16_t* O; int ldc; const float* bias; int split_cols; size_t split_stride; float scale0;
    __device__ __forceinline__ void operator()(const f32x4 (&acc)[2][2][4][2], const Unit& u, int wr, int wc, int fr, int fq) const {
        const int row0 = u.pm * BM + wr * 64 + fr; int colt = u.pn * BM; bf16_t* base = O;
        float sc = 1.f; if (split_cols) { const int t = colt / split_cols; base += (size_t)t * split_stride; colt -= t * split_cols; if (t == 0) sc = scale0; }
        const int col0 = colt + wc * 32 + 8 * fq, bcol0 = u.pn * BM + wc * 32 + 8 * fq;
        f32x4 bv[2][2];
#pragma unroll
        for (int bj = 0; bj < 2; ++bj)
#pragma unroll
            for (int n = 0; n < 2; ++n) bv[bj][n] = bias ? *(const f32x4*)(bias + bcol0 + bj * HALF + 4 * n) : (f32x4){0.f, 0.f, 0.f, 0.f};
#pragma unroll
        for (int ai = 0; ai < 2; ++ai)
#pragma unroll
            for (int m = 0; m < 4; ++m) { bf16_t* rowp = base + (size_t)(row0 + ai * HALF + m * 16) * ldc + col0;
#pragma unroll
                for (int bj = 0; bj < 2; ++bj) { f32x4 v0 = acc[ai][bj][m][0] + bv[bj][0], v1 = acc[ai][bj][m][1] + bv[bj][1];
                    if (ACT == 1) { f32x2 a = gelu_pk((f32x2){v0[0], v0[1]}), b = gelu_pk((f32x2){v0[2], v0[3]}), c = gelu_pk((f32x2){v1[0], v1[1]}), d = gelu_pk((f32x2){v1[2], v1[3]});
                        v0 = (f32x4){a.x, a.y, b.x, b.y}; v1 = (f32x4){c.x, c.y, d.x, d.y}; }
                    v0 = v0 * sc; v1 = v1 * sc; u32x4 w; w.x = cvt_pk_bf16(v0[0], v0[1]); w.y = cvt_pk_bf16(v0[2], v0[3]); w.z = cvt_pk_bf16(v1[0], v1[1]); w.w = cvt_pk_bf16(v1[2], v1[3]);
                    *(u32x4*)(rowp + bj * HALF) = w; } }
    }
};

struct PanelStats {
    unsigned* xbuf;
    unsigned* cnt;
    unsigned* tmo;
    int ntn; float eps;
    unsigned code;
    __device__ __forceinline__ bool run(const f32x4 (&v)[2][2][4][2], const Unit& u, int wr, int wc, int fr, int fq, PG8_LAS unsigned char* lds, int wid, int lane) const {
        typedef float f32x2v __attribute__((ext_vector_type(2)));
        PG8_LAS f32x2v* P = (PG8_LAS f32x2v*)lds;
        PG8_LAS f32x2v* S = (PG8_LAS f32x2v*)(lds + 8192);
        PG8_LAS unsigned* flag = (PG8_LAS unsigned*)(lds + 8192 + 2048);
#pragma unroll
        for (int ai = 0; ai < 2; ++ai)
#pragma unroll
            for (int m = 0; m < 4; ++m) {
                float s = 0.f;
#pragma unroll
                for (int bj = 0; bj < 2; ++bj)
#pragma unroll
                    for (int n = 0; n < 2; ++n) { const f32x4 x = v[ai][bj][m][n]; s += (x[0] + x[1]) + (x[2] + x[3]); }
                s += __shfl_xor(s, 16); s += __shfl_xor(s, 32);
                const float mw = s * (1.0f / 64.0f); float q = 0.f;
#pragma unroll
                for (int bj = 0; bj < 2; ++bj)
#pragma unroll
                    for (int n = 0; n < 2; ++n) { const f32x4 d = v[ai][bj][m][n] - mw; q += (d[0] * d[0] + d[1] * d[1]) + (d[2] * d[2] + d[3] * d[3]); }
                q += __shfl_xor(q, 16); q += __shfl_xor(q, 32);
                if (fq == 0) P[(ai * HALF + wr * 64 + m * 16 + fr) * 4 + wc] = (f32x2v){mw, q};
            }
        asm volatile("s_waitcnt lgkmcnt(0)" ::: "memory"); __builtin_amdgcn_s_barrier(); asm volatile("" ::: "memory");
#if defined(BROKEN_EXCHANGE_NO_WAIT)
#warning BROKEN CONTROL BUILD: the row-statistics exchange does not wait; results are wrong by design
        if (blockIdx.x >= 64) { const long long t0_ = clock64(); while (clock64() - t0_ < 60000) __builtin_amdgcn_s_sleep(8); }
#endif
        const int row = wid * 32 + (lane & 31);
        if (lane < 32) {
            const f32x2v a = P[row * 4 + 0], b = P[row * 4 + 1], c = P[row * 4 + 2], d = P[row * 4 + 3];
            const float mt = (a.x + b.x + c.x + d.x) * 0.25f;
            const float da = a.x - mt, db = b.x - mt, dc = c.x - mt, dd = d.x - mt;
            const float m2 = (a.y + b.y) + (c.y + d.y) + 64.0f * ((da * da + db * db) + (dc * dc + dd * dd));
            unsigned long long* slot = (unsigned long long*)xbuf + ((size_t)(u.pm * BM + row) * 4 + u.pn);
            __hip_atomic_store(slot, ((unsigned long long)__float_as_uint(m2) << 32) | __float_as_uint(mt), __ATOMIC_RELAXED, __HIP_MEMORY_SCOPE_AGENT);
        }
        asm volatile("s_waitcnt vmcnt(0)" ::: "memory");
        if (lane == 0) __hip_atomic_fetch_add(cnt + 64 * u.pm, 1u, __ATOMIC_RELAXED, __HIP_MEMORY_SCOPE_AGENT);
        if (wid == 0) {
            bool dead = false; const unsigned long long t0 = __builtin_amdgcn_s_memrealtime(); const unsigned want = 8u * (unsigned)ntn;
            for (;;) {
#if defined(BROKEN_EXCHANGE_NO_WAIT)
                break;
#endif
                if ((unsigned)__builtin_amdgcn_readfirstlane(__hip_atomic_load(cnt + 64 * u.pm, __ATOMIC_RELAXED, __HIP_MEMORY_SCOPE_AGENT)) >= want) break;
                if (__builtin_amdgcn_s_memrealtime() - t0 > 2000000ull) {
                    if (lane == 0) { unsigned expect = 0u; __hip_atomic_compare_exchange_strong(tmo + 1, &expect, code | (unsigned)(u.pm & 0xff), __ATOMIC_RELAXED, __ATOMIC_RELAXED, __HIP_MEMORY_SCOPE_AGENT);
                                     __hip_atomic_store(tmo, 1u, __ATOMIC_RELAXED, __HIP_MEMORY_SCOPE_AGENT); }
                    dead = true; break; }
                __builtin_amdgcn_s_sleep(2);
            }
            __builtin_amdgcn_fence(__ATOMIC_ACQUIRE, "agent");
            if (lane == 0) flag[0] = dead ? 1u : 0u;
        }
        asm volatile("s_waitcnt vmcnt(0) lgkmcnt(0)" ::: "memory"); __builtin_amdgcn_s_barrier(); asm volatile("" ::: "memory");
        const bool bad = flag[0] != 0u;
        if (lane < 32) {
            const unsigned long long* slot = (const unsigned long long*)xbuf + (size_t)(u.pm * BM + row) * 4; float mt[4], m2[4]; float ms = 0.f;
#pragma unroll
            for (int t = 0; t < 4; ++t) { if (t < ntn) { const unsigned long long w = __hip_atomic_load(slot + t, __ATOMIC_RELAXED, __HIP_MEMORY_SCOPE_AGENT); mt[t] = __uint_as_float((unsigned)w); m2[t] = __uint_as_float((unsigned)(w >> 32)); } else { mt[t] = 0.f; m2[t] = 0.f; } ms += mt[t]; }
            const float mean = ms / (float)ntn; float q = 0.f;
#pragma unroll
            for (int t = 0; t < 4; ++t) if (t < ntn) { const float dm = mt[t] - mean; q += m2[t] + 256.0f * dm * dm; }
            S[row] = (f32x2v){mean, 1.0f / sqrtf(q / (256.0f * (float)ntn) + eps)};
        }
        asm volatile("s_waitcnt lgkmcnt(0)" ::: "memory"); __builtin_amdgcn_s_barrier(); asm volatile("" ::: "memory");
        return bad;
    }
};
struct EpiLnRes {
    static constexpr bool PERM = false, AFTER_DRAIN = true;
    const float* base; float* out; int ldc; const float* bias; PanelStats st; unsigned poison;
    __device__ __forceinline__ void fused(f32x4 (&acc)[2][2][4][2], const Unit& u, int wr, int wc, int fr, int fq, PG8_LAS unsigned char* lds, int wid, int lane) const {
        typedef float f32x2v __attribute__((ext_vector_type(2)));
        const PG8_LAS f32x2v* S = (const PG8_LAS f32x2v*)(lds + 8192);
        const int col0 = u.pn * BM + wc * 32 + 4 * fq;
#pragma unroll
        for (int bj = 0; bj < 2; ++bj)
#pragma unroll
            for (int n = 0; n < 2; ++n) { const f32x4 bv = bias ? *(const f32x4*)(bias + col0 + bj * HALF + n * 16) : (f32x4){0.f, 0.f, 0.f, 0.f};
#pragma unroll
                for (int ai = 0; ai < 2; ++ai)
#pragma unroll
                    for (int m = 0; m < 4; ++m) acc[ai][bj][m][n] += bv; }
        f32x4 pre[4][2][2];
#pragma unroll
        for (int m = 0; m < 4; ++m) { const size_t off = (size_t)(u.pm * BM + wr * 64 + m * 16 + fr) * ldc + col0;
#pragma unroll
            for (int bj = 0; bj < 2; ++bj)
#pragma unroll
                for (int n = 0; n < 2; ++n) pre[m][bj][n] = *(const f32x4*)(base + off + bj * HALF + n * 16); }
        const bool bad = st.run(acc, u, wr, wc, fr, fq, lds, wid, lane) || poison != 0u;
        const float qnan = __builtin_nanf("");
#pragma unroll
        for (int ai = 0; ai < 2; ++ai)
#pragma unroll
            for (int m = 0; m < 4; ++m) { const int r = ai * HALF + wr * 64 + m * 16 + fr; const f32x2v sr = S[r]; const size_t off = (size_t)(u.pm * BM + r) * ldc + col0;
#pragma unroll
                for (int bj = 0; bj < 2; ++bj)
#pragma unroll
                    for (int n = 0; n < 2; ++n) { const f32x4 bs = ai == 0 ? pre[m][bj][n] : *(const f32x4*)(base + off + bj * HALF + n * 16); f32x4 o = bs + (acc[ai][bj][m][n] - sr.x) * sr.y;
                        if (bad) o = (f32x4){qnan, qnan, qnan, qnan}; *(f32x4*)(out + off + bj * HALF + n * 16) = o; }
                if (m & 1) asm volatile("" ::: "memory"); }
    }
};
struct EpiLnResLn {
    static constexpr bool PERM = false, AFTER_DRAIN = true;
    const float* base; float* out; bf16_t* xn; int ldc; const float* bias; PanelStats st1, st2; unsigned poison;
    __device__ __forceinline__ void fused(f32x4 (&acc)[2][2][4][2], const Unit& u, int wr, int wc, int fr, int fq, PG8_LAS unsigned char* lds, int wid, int lane) const {
        typedef float f32x2v __attribute__((ext_vector_type(2))); typedef unsigned u32x2v __attribute__((ext_vector_type(2)));
        const PG8_LAS f32x2v* S = (const PG8_LAS f32x2v*)(lds + 8192);
        const int col0 = u.pn * BM + wc * 32 + 4 * fq;
#pragma unroll
        for (int bj = 0; bj < 2; ++bj)
#pragma unroll
            for (int n = 0; n < 2; ++n) { const f32x4 bv = bias ? *(const f32x4*)(bias + col0 + bj * HALF + n * 16) : (f32x4){0.f, 0.f, 0.f, 0.f};
#pragma unroll
                for (int ai = 0; ai < 2; ++ai)
#pragma unroll
                    for (int m = 0; m < 4; ++m) acc[ai][bj][m][n] += bv; }
        bool bad = st1.run(acc, u, wr, wc, fr, fq, lds, wid, lane) || poison != 0u;
        const float qnan = __builtin_nanf("");
#pragma unroll
        for (int ai = 0; ai < 2; ++ai)
#pragma unroll
            for (int m = 0; m < 4; ++m) { const int r = ai * HALF + wr * 64 + m * 16 + fr; const f32x2v sr = S[r]; const size_t off = (size_t)(u.pm * BM + r) * ldc + col0;
#pragma unroll
                for (int bj = 0; bj < 2; ++bj)
#pragma unroll
                    for (int n = 0; n < 2; ++n) { const f32x4 bs = *(const f32x4*)(base + off + bj * HALF + n * 16); acc[ai][bj][m][n] = bs + (acc[ai][bj][m][n] - sr.x) * sr.y; }
                asm volatile("" : "+v"(acc[ai][0][m][0]), "+v"(acc[ai][0][m][1]), "+v"(acc[ai][1][m][0]), "+v"(acc[ai][1][m][1]));
                if (m & 1) asm volatile("" ::: "memory"); }
        const bool bad1 = bad;
        bad = st2.run(acc, u, wr, wc, fr, fq, lds, wid, lane) || bad;
#pragma unroll
        for (int ai = 0; ai < 2; ++ai)
#pragma unroll
            for (int m = 0; m < 4; ++m) { const int r = ai * HALF + wr * 64 + m * 16 + fr; const f32x2v sr = S[r]; const size_t off = (size_t)(u.pm * BM + r) * ldc + col0;
#pragma unroll
                for (int bj = 0; bj < 2; ++bj)
#pragma unroll
                    for (int n = 0; n < 2; ++n) { const f32x4 x1 = acc[ai][bj][m][n]; *(f32x4*)(out + off + bj * HALF + n * 16) = bad1 ? (f32x4){qnan, qnan, qnan, qnan} : x1;
                        const f32x4 o = (x1 - sr.x) * sr.y; u32x2v w; w.x = cvt_pk_bf16(o[0], o[1]); w.y = cvt_pk_bf16(o[2], o[3]);
                        if (bad) { w.x = 0x7fc07fc0u; w.y = 0x7fc07fc0u; } *(u32x2v*)(xn + off + bj * HALF + n * 16) = w; }
                asm volatile("" ::: "memory"); }
    }
};

template <class Epi, class Sched, bool ALIGN_EPI = false, bool SP2 = false>
__device__ __forceinline__ void gemm_phase(PG8_LAS unsigned char* lds, const Gemm g, const Sched& S, const Epi& E, int tid_in) {
    int tid_l = tid_in; asm volatile("" : "+v"(tid_l));
    const int tid = tid_l, wid = __builtin_amdgcn_readfirstlane(tid >> 6), lane = tid & 63, wr = wid >> 2, wc = wid & 3, fr = lane & 15, fq = lane >> 4;
    const int K = g.K, nt = K / BK;
    unsigned voffA[2], voffB[2];
#pragma unroll
    for (int i = 0; i < 2; ++i) { int R, C; stage_rc(tid * 16 + i * 8192, R, C); const int Rb = Epi::PERM ? ((R & ~31) + perm32(R & 31)) : R;
        voffA[i] = (unsigned)(R * K + C) * 2u; voffB[i] = (unsigned)(Rb * K + C) * 2u; }
    const size_t kstep = (size_t)(BK * 2);
    const size_t hstep = (size_t)HALF * K * 2;
    const size_t tstep = 2 * hstep;
    const unsigned ldsw = (unsigned)wid * 1024u;
    const int aoff = lds_byte(wr * 64 + fr, fq * 8), boff = lds_byte(wc * 32 + fr, fq * 8);
#define PG8_SA(b, h) (((b) * 2 + (h)) * HTB)
#define PG8_SB(b, h) ((4 + (b) * 2 + (h)) * HTB)
#define PG8_STAGE(bufoff, gbase, voff) do { _Pragma("unroll") for (int _i = 0; _i < 2; ++_i) \
        __builtin_amdgcn_global_load_lds((const unsigned*)((const char*)(gbase) + (voff)[_i]), (PG8_LAS unsigned*)(lds + (bufoff) + ldsw + _i * 8192), 16, 0, 0); } while (0)
#define PG8_LDA(dst, b, h) do { _Pragma("unroll") for (int m = 0; m < 4; ++m) _Pragma("unroll") for (int k = 0; k < 2; ++k) dst[m][k] = *(const PG8_LAS bf16x8*)(lds + PG8_SA(b, h) + aoff + m * 2048 + k * 1024); } while (0)
#define PG8_LDB(dst, b, h) do { _Pragma("unroll") for (int n = 0; n < 2; ++n) _Pragma("unroll") for (int k = 0; k < 2; ++k) dst[n][k] = *(const PG8_LAS bf16x8*)(lds + PG8_SB(b, h) + boff + n * 2048 + k * 1024); } while (0)
#define PG8_MMA(ai, bj, At, Bt) do { __builtin_amdgcn_s_setprio(1); _Pragma("unroll") for (int m = 0; m < 4; ++m) _Pragma("unroll") for (int n = 0; n < 2; ++n) _Pragma("unroll") for (int k = 0; k < 2; ++k) \
        acc[ai][bj][m][n] = __builtin_amdgcn_mfma_f32_16x16x32_bf16(Bt[n][k], At[m][k], acc[ai][bj][m][n], 0, 0, 0); __builtin_amdgcn_s_setprio(0); } while (0)
#define PG8_WAIT_V(n) asm volatile("s_waitcnt vmcnt(" #n ")" ::: "memory")
#define PG8_WAIT_L(n) asm volatile("s_waitcnt lgkmcnt(" #n ")" ::: "memory")
#define PG8_BAR __builtin_amdgcn_s_barrier()
#define PG8_SCHED __builtin_amdgcn_sched_barrier(0)
    Unit cur, nxt; int ui = 0;
    if (!S.next(0, cur)) return;
    f32x4 acc[2][2][4][2];
#pragma unroll
    for (int a = 0; a < 2; ++a)
#pragma unroll
        for (int b = 0; b < 2; ++b)
#pragma unroll
            for (int m = 0; m < 4; ++m)
#pragma unroll
                for (int n = 0; n < 2; ++n) acc[a][b][m][n] = (f32x4){0.f, 0.f, 0.f, 0.f};
    bf16x8 At[4][2], B0[2][2], B1[2][2];
    const char* cA = (const char*)g.A + (size_t)cur.pm * tstep; const char* cB = (const char*)g.Bt + (size_t)cur.pn * tstep;
    S.a_ready(cur);
    if constexpr (Epi::INIT) E.init_load(acc, cur, wr, wc, fr, fq);
    if constexpr (SP2) {
        PG8_STAGE(PG8_SB(0, 0), cB, voffB); PG8_STAGE(PG8_SB(0, 1), cB + hstep, voffB); PG8_STAGE(PG8_SA(0, 0), cA, voffA); PG8_STAGE(PG8_SA(0, 1), cA + hstep, voffA);
        if (wr == 1) PG8_BAR;
        PG8_WAIT_V(2); PG8_BAR;
        PG8_STAGE(PG8_SB(1, 0), cB + kstep, voffB); PG8_STAGE(PG8_SA(1, 0), cA + kstep, voffA); PG8_STAGE(PG8_SB(1, 1), cB + hstep + kstep, voffB);
        PG8_WAIT_V(6); PG8_BAR;
    } else {
        PG8_STAGE(PG8_SB(0, 0), cB, voffB); PG8_STAGE(PG8_SA(0, 0), cA, voffA); PG8_STAGE(PG8_SB(0, 1), cB + hstep, voffB); PG8_STAGE(PG8_SA(0, 1), cA + hstep, voffA);
        if (wr == 1) PG8_BAR;
        PG8_WAIT_V(4); PG8_BAR;
        PG8_STAGE(PG8_SB(1, 0), cB + kstep, voffB); PG8_STAGE(PG8_SA(1, 0), cA + kstep, voffA); PG8_STAGE(PG8_SB(1, 1), cB + hstep + kstep, voffB);
        PG8_WAIT_V(6); PG8_BAR;
    }
    if constexpr (Epi::INIT) E.init_scale(acc, cur, wr, wc, fr, fq);
    for (;;) {
        const bool has_next = S.next(ui + 1, nxt);
        const char* nA = has_next ? (const char*)g.A + (size_t)nxt.pm * tstep : cA; const char* nB = has_next ? (const char*)g.Bt + (size_t)nxt.pn * tstep : cB;
        for (int t = 0; t < nt; t += 2) {
            const bool last = (t == nt - 2);
            const char* a1 = cA + (size_t)(t + 1) * kstep;
            const char* a2 = last ? nA : cA + (size_t)(t + 2) * kstep; const char* b2 = last ? nB : cB + (size_t)(t + 2) * kstep;
            const char* a3 = a2 + kstep; const char* b3 = b2 + kstep;
            if (last && has_next) S.a_ready(nxt);
            if constexpr (SP2) {
            PG8_LDB(B0, 0, 0); PG8_LDB(B1, 0, 1); PG8_SCHED; PG8_LDA(At, 0, 0); PG8_STAGE(PG8_SA(1, 1), a1 + hstep, voffA);
            PG8_WAIT_V(8); PG8_WAIT_L(0); PG8_BAR; PG8_MMA(0, 0, At, B0); PG8_MMA(0, 1, At, B1); PG8_BAR; PG8_SCHED;
            PG8_LDA(At, 0, 1); PG8_STAGE(PG8_SB(0, 0), b2, voffB); PG8_STAGE(PG8_SB(0, 1), b2 + hstep, voffB); PG8_STAGE(PG8_SA(0, 0), a2, voffA);
            PG8_WAIT_V(8); PG8_WAIT_L(0); PG8_BAR; PG8_MMA(1, 0, At, B0); PG8_MMA(1, 1, At, B1); PG8_BAR; PG8_SCHED;
            PG8_LDB(B0, 1, 0); PG8_LDB(B1, 1, 1); PG8_SCHED; PG8_LDA(At, 1, 0); PG8_STAGE(PG8_SA(0, 1), a2 + hstep, voffA);
            PG8_WAIT_V(8); PG8_WAIT_L(0); PG8_BAR; PG8_MMA(0, 0, At, B0); PG8_MMA(0, 1, At, B1); PG8_BAR; PG8_SCHED;
            PG8_LDA(At, 1, 1); PG8_STAGE(PG8_SB(1, 0), b3, voffB); PG8_STAGE(PG8_SB(1, 1), b3 + hstep, voffB); PG8_STAGE(PG8_SA(1, 0), a3, voffA);
            PG8_WAIT_V(8); PG8_WAIT_L(0); PG8_BAR; PG8_MMA(1, 0, At, B0); PG8_MMA(1, 1, At, B1); PG8_BAR; PG8_SCHED;
            } else {
            PG8_LDB(B0, 0, 0); PG8_SCHED; PG8_LDA(At, 0, 0); PG8_STAGE(PG8_SA(1, 1), a1 + hstep, voffA);
            PG8_WAIT_L(8); PG8_BAR; PG8_WAIT_L(0); PG8_MMA(0, 0, At, B0); PG8_BAR; PG8_SCHED;
            PG8_LDB(B1, 0, 1); PG8_STAGE(PG8_SB(0, 0), b2, voffB);
            PG8_BAR; PG8_WAIT_L(0); PG8_MMA(0, 1, At, B1); PG8_BAR;
            PG8_LDA(At, 0, 1); PG8_STAGE(PG8_SA(0, 0), a2, voffA);
            PG8_BAR; PG8_WAIT_L(0); PG8_MMA(1, 0, At, B0); PG8_BAR; PG8_SCHED;
            PG8_STAGE(PG8_SB(0, 1), b2 + hstep, voffB);
            PG8_WAIT_V(6); PG8_BAR; PG8_MMA(1, 1, At, B1); PG8_BAR;
            PG8_LDB(B0, 1, 0); PG8_SCHED; PG8_LDA(At, 1, 0); PG8_STAGE(PG8_SA(0, 1), a2 + hstep, voffA);
            PG8_WAIT_L(8); PG8_BAR; PG8_WAIT_L(0); PG8_MMA(0, 0, At, B0); PG8_BAR; PG8_SCHED;
            PG8_LDB(B1, 1, 1); PG8_STAGE(PG8_SB(1, 0), b3, voffB);
            PG8_BAR; PG8_WAIT_L(0); PG8_MMA(0, 1, At, B1); PG8_BAR;
            PG8_LDA(At, 1, 1); PG8_STAGE(PG8_SA(1, 0), a3, voffA);
            PG8_BAR; PG8_WAIT_L(0); PG8_MMA(1, 0, At, B0); PG8_BAR; PG8_SCHED;
            PG8_STAGE(PG8_SB(1, 1), b3 + hstep, voffB);
            PG8_WAIT_V(6); PG8_BAR; PG8_MMA(1, 1, At, B1); PG8_BAR;
            }
        }
        if constexpr (ALIGN_EPI) { if (wr == 0) PG8_BAR; }
        if constexpr (!Epi::AFTER_DRAIN) { E(acc, cur, wr, wc, fr, fq); S.done(cur); }
        if (!has_next) break;
        bool keep_acc = false;
        if constexpr (Epi::KEEP) keep_acc = E.keep(cur);
        if (!keep_acc) {
#pragma unroll
        for (int a = 0; a < 2; ++a)
#pragma unroll
            for (int b = 0; b < 2; ++b)
#pragma unroll
                for (int m = 0; m < 4; ++m)
#pragma unroll
                    for (int n = 0; n < 2; ++n) acc[a][b][m][n] = (f32x4){0.f, 0.f, 0.f, 0.f};
        }
        cur = nxt; cA = nA; cB = nB; ++ui;
        if constexpr (ALIGN_EPI) { if (wr == 1) PG8_BAR; }
    }
    PG8_WAIT_V(0);
    if constexpr (!ALIGN_EPI) { if (wr == 0) PG8_BAR; }
    PG8_BAR;
    if constexpr (Epi::AFTER_DRAIN) { E.fused(acc, cur, wr, wc, fr, fq, lds, wid, lane); S.done(cur); }
#undef PG8_SA
#undef PG8_SB
#undef PG8_STAGE
#undef PG8_LDA
#undef PG8_LDB
#undef PG8_MMA
#undef PG8_WAIT_V
#undef PG8_WAIT_L
#undef PG8_BAR
#undef PG8_SCHED
}
}

#define LAS __attribute__((address_space(3)))
typedef unsigned short bf16_t;
typedef short bf16x8 __attribute__((ext_vector_type(8)));
typedef short s16x4 __attribute__((ext_vector_type(4)));
typedef float f32x16 __attribute__((ext_vector_type(16)));
typedef float f32x4 __attribute__((ext_vector_type(4)));
typedef float f32x2 __attribute__((ext_vector_type(2)));
typedef unsigned u32x4 __attribute__((ext_vector_type(4)));
typedef unsigned u32x2 __attribute__((ext_vector_type(2)));

constexpr int DM = 1024, NBATCH = 8, SEQ = 2048, MTOK = NBATCH * SEQ, DEPTH = 4, NIN = 5912, NINP = 6144;
constexpr float RMS_EPS = 1e-6f, NEGF = -1e30f;
constexpr size_t MiB = 1u << 20;
constexpr size_t WS_MOD = 0;
constexpr size_t WS_BAR = 768 * 1024;
constexpr size_t WS_B1P = 512 * 1024;
constexpr size_t WS_B1 = 640 * 1024;
constexpr size_t WS_ROPE = 1 * MiB;
constexpr size_t WS_W2T = 2 * MiB;
constexpr size_t WS_KC = 2 * MiB + 256 * 1024;
constexpr size_t WS_VC = 2 * MiB + 512 * 1024;
constexpr size_t WS_NG = 3 * MiB;
constexpr size_t WS_W1T = 5 * MiB;
constexpr size_t WS_WABT = 9 * MiB;
constexpr size_t WS_WOT = 17 * MiB;
constexpr size_t WS_WINT = 25 * MiB;
constexpr size_t WS_H = 73 * MiB;
constexpr size_t WS_Y = WS_H;
constexpr size_t WS_SBQ = 105 * MiB, WS_SBK = 121 * MiB, WS_SBV = 137 * MiB, WS_NQ = 153 * MiB;
constexpr size_t WS_YA = WS_SBQ;
constexpr size_t WS_SBZ = 169 * MiB, WS_NZ = 185 * MiB;
constexpr size_t WS_MA = 201 * MiB, WS_MB = 233 * MiB;
constexpr size_t WS_KCR = 265 * MiB, WS_VCR = 269 * MiB, WS_KS = 273 * MiB, WS_VS = 277 * MiB, WS_KW = 281 * MiB, WS_VW = 285 * MiB;
constexpr size_t WS_AACT = 289 * MiB, WS_BACT = 305 * MiB;
constexpr size_t WS_SSQ = 321 * MiB;
constexpr size_t WS_END = 322 * MiB;
constexpr int LDS_BYTES = 131072 + 4096;

#ifndef PROBE_K
#define PROBE_K 99
#define PROBE_N 1
#endif
struct Args { const float* in[19]; float* out; unsigned char* ws; int ph_lo, ph_hi, use_cg, pad; };

__device__ __forceinline__ unsigned f2bf(float f) { unsigned u = __builtin_bit_cast(unsigned, f); return (u + 0x7fffu + ((u >> 16) & 1u)) >> 16; }
typedef __bf16 bf16x2_t __attribute__((ext_vector_type(2)));
__device__ __forceinline__ unsigned pk2(float lo, float hi) { f32x2 v = {lo, hi}; bf16x2_t b = __builtin_convertvector(v, bf16x2_t); return __builtin_bit_cast(unsigned, b); }
__device__ __forceinline__ float bf_lo(unsigned w) { return __builtin_bit_cast(float, w << 16); }
__device__ __forceinline__ float bf_hi(unsigned w) { return __builtin_bit_cast(float, w & 0xffff0000u); }
__device__ __forceinline__ float sigmoidf_(float x) { return __builtin_amdgcn_rcpf(1.0f + __expf(-x)); }
__device__ __forceinline__ float siluf_(float x) { return x * sigmoidf_(x); }
__device__ __forceinline__ float wave_sum(float v) {
#pragma unroll
    for (int o = 1; o < 64; o <<= 1) v += __shfl_xor(v, o);
    return v;
}
#define LDS_WAIT() asm volatile("s_waitcnt lgkmcnt(0)" ::: "memory")
__device__ __forceinline__ void st16_wt(void* p, u32x4 v) { *(u32x4*)p = v; }
__device__ __forceinline__ void st8_wt(void* p, u32x2 v) { *(u32x2*)p = v; }
constexpr float QSCALE = 0.125f * 1.4426950408889634f;

struct TItem { const float* W; bf16_t* WT; int ldw, n0, nv, K, k0, drow, frag; };
__device__ __forceinline__ void titem_load(const TItem& t, float (&tv)[32], int lane) {
    const int cidx = lane & 31;
#pragma unroll
    for (int i = 0; i < 32; ++i) { const int kk = 2 * i + (lane >> 5); tv[i] = 0.f; if (cidx < t.nv) tv[i] = t.W[(size_t)(t.k0 + kk) * t.ldw + t.n0 + cidx]; }
}
__device__ __forceinline__ void titem_finish(const TItem& t, const float (&tv)[32], LAS float* scr, int lane) {
    const int cidx = lane & 31;
#pragma unroll
    for (int i = 0; i < 32; ++i) { const int kk = 2 * i + (lane >> 5); scr[kk * 33 + cidx] = tv[i]; }
    LDS_WAIT();
    const int c = lane & 7;
#pragma unroll
    for (int j = 0; j < 4; ++j) { const int n = (lane >> 3) + 8 * j; const LAS float* sp = scr + (8 * c) * 33 + n;
        u32x4 o; o.x = pk2(sp[0 * 33], sp[1 * 33]); o.y = pk2(sp[2 * 33], sp[3 * 33]); o.z = pk2(sp[4 * 33], sp[5 * 33]); o.w = pk2(sp[6 * 33], sp[7 * 33]);
        size_t dsto = (size_t)(t.drow + n) * t.K + t.k0 + 8 * c;
        if (t.frag) { const int ng = t.drow + n, k = t.k0 + 8 * c;
            dsto = (size_t)((((((ng >> 6) * 4 + ((ng >> 4) & 3)) * 4 + (k >> 9)) * 16 + ((k >> 5) & 15)) * 64 + ((k >> 3) & 3) * 16 + (ng & 15))) * 8; }
        *(u32x4*)(t.WT + dsto) = o; }
    LDS_WAIT();
}
__device__ __forceinline__ TItem titem_decode(const Args& a, unsigned char* ws, int it) {
    constexpr int I_IN = 4 * 96 * 2 * 16, I_AB = 2 * 4 * 8 * 32, I_O = 4 * 16 * 32, I_1 = 8 * 32 * 4;
    TItem t; t.frag = 0; int r = it;
    if (r < I_IN) {
        const int l = r / 3072; r %= 3072; const int H = r >> 5, hh = (r >> 4) & 1, kb = r & 15;
        int srcb, nv = 32;
        if (H < 60) srcb = 64 * H; else if (H < 76) srcb = 3864 + 64 * (H - 60); else if (H < 92) srcb = 4888 + 64 * (H - 76); else { srcb = 3840; nv = (H == 92 && hh == 0) ? 24 : 0; }
        t.W = a.in[5] + (size_t)l * 1024 * NIN; t.ldw = NIN; t.n0 = srcb + 32 * hh; t.nv = nv; t.WT = (bf16_t*)(ws + WS_WINT) + (size_t)l * NINP * 1024; t.K = 1024; t.k0 = 64 * kb; t.drow = 256 * (H >> 2) + 128 * hh + 32 * (H & 3);
        return t;
    }
    r -= I_IN;
    if (r < I_AB) {
        const int which = r / 1024; r %= 1024; const int l = r / 256; r %= 256; const int kb = r / 32, nb = r % 32;
        t.W = a.in[which ? 17 : 16] + (size_t)l * 512 * 1024; t.ldw = 1024; t.n0 = 32 * nb; t.nv = 32; t.WT = (bf16_t*)(ws + WS_WABT) + (size_t)l * 2048 * 512; t.K = 512; t.k0 = 64 * kb; t.drow = 1024 * which + 32 * nb;
        return t;
    }
    r -= I_AB;
    if (r < I_O) {
        const int l = r / 512; r %= 512; const int kb = r / 32, nb = r % 32;
        t.W = a.in[18] + (size_t)l * 1024 * 1024; t.ldw = 1024; t.n0 = 32 * nb; t.nv = 32; t.WT = (bf16_t*)(ws + WS_WOT) + (size_t)l * 1024 * 1024; t.K = 1024; t.k0 = 64 * kb; t.drow = 32 * nb;
        return t;
    }
    r -= I_O;
    if (r < I_1) {
        const int lk = r / 128; r %= 128; const int kb = r / 4, nb = r % 4; const int l = lk >> 1, kv = lk & 1;
        t.W = a.in[kv ? 14 : 11] + (size_t)l * 2048 * 128; t.ldw = 128; t.n0 = 32 * nb; t.nv = 32; t.WT = (bf16_t*)(ws + WS_W1T) + (size_t)lk * 128 * 2048; t.K = 2048; t.k0 = 64 * kb; t.drow = 32 * nb; t.frag = 1;
        return t;
    }
    r -= I_1;
    { const int lk = r / 4; r %= 4; const int kb = r / 2, nb = r % 2; const int l = lk >> 1, kv = lk & 1;
      t.W = a.in[kv ? 15 : 12] + (size_t)l * 128 * 64; t.ldw = 64; t.n0 = 32 * nb; t.nv = 32; t.WT = (bf16_t*)(ws + WS_W2T) + (size_t)lk * 64 * 128; t.K = 128; t.k0 = 64 * kb; t.drow = 32 * nb; }
    return t;
}

__device__ __forceinline__ void phase0(const Args& a, unsigned char* ws, LAS unsigned char* L, int tid, int lane, int wid) {
    {
        LAS float* sc = (LAS float*)L; LAS float* red = (LAS float*)(L + 32768);
        const float* c = a.in[1]; const float* ada_w = a.in[2]; const float* ada_b = a.in[3]; float* mod = (float*)(ws + WS_MOD);
        if ((int)blockIdx.x < 192) {
            for (int i = tid; i < 8192; i += 512) sc[i] = siluf_(c[i]);
            __syncthreads();
        }
        for (int u = blockIdx.x; u < 192; u += gridDim.x) {
            const int l = u / 48, cgp = u % 48, col = cgp * 64 + (tid & 63), ks = tid >> 6;
            float acc[8];
#pragma unroll
            for (int b = 0; b < 8; ++b) acc[b] = 0.f;
            const float* wp = ada_w + ((size_t)l * 1024 + ks * 128) * 3072 + col;
#pragma unroll 16
            for (int k = 0; k < 128; ++k) { const float w = wp[(size_t)k * 3072];
#pragma unroll
                for (int b = 0; b < 8; ++b) acc[b] += sc[b * 1024 + ks * 128 + k] * w; }
#pragma unroll
            for (int b = 0; b < 8; ++b) red[(ks * 8 + b) * 64 + (tid & 63)] = acc[b];
            __syncthreads();
            { const int b = tid >> 6, cc = tid & 63; float s = 0.f;
#pragma unroll
              for (int k2 = 0; k2 < 8; ++k2) s += red[(k2 * 8 + b) * 64 + cc];
              __hip_atomic_store(mod + ((size_t)l * 8 + b) * 3072 + cgp * 64 + cc, s + ada_b[l * 3072 + cgp * 64 + cc], __ATOMIC_RELAXED, __HIP_MEMORY_SCOPE_AGENT); }
            asm volatile("s_waitcnt vmcnt(0)" ::: "memory");
            __syncthreads();
            if (l == 0 && tid == 0) __hip_atomic_fetch_add((unsigned*)(ws + WS_BAR) + 3456, 1u, __ATOMIC_RELAXED, __HIP_MEMORY_SCOPE_AGENT);
        }
    }
    {
        __syncthreads();
        LAS float* redb = (LAS float*)(L + 32768);
        for (int u = (int)gridDim.x - 1 - (int)blockIdx.x; u < 128; u += gridDim.x) {
            const int lk = u >> 4, sl = u & 15, l = lk >> 1, kv = lk & 1, hcol = tid & 127, sub = tid >> 7;
            const float* pe = a.in[kv ? 13 : 10] + (size_t)l * 2048 + sl * 128 + sub * 32; const float* w1 = a.in[kv ? 14 : 11] + ((size_t)l * 2048 + sl * 128 + sub * 32) * 128 + hcol;
            float acc = 0.f;
#pragma unroll 16
            for (int f = 0; f < 32; ++f) acc += pe[f] * w1[(size_t)f * 128];
            redb[sub * 128 + hcol] = acc;
            __syncthreads();
            if (tid < 128) __hip_atomic_store((float*)(ws + WS_B1P) + (lk * 16 + sl) * 128 + tid, (redb[tid] + redb[128 + tid]) + (redb[256 + tid] + redb[384 + tid]), __ATOMIC_RELAXED, __HIP_MEMORY_SCOPE_AGENT);
            asm volatile("s_waitcnt vmcnt(0)" ::: "memory");
            __syncthreads();
            if (tid == 0) __hip_atomic_fetch_add((unsigned*)(ws + WS_BAR) + 3520, 1u, __ATOMIC_RELAXED, __HIP_MEMORY_SCOPE_AGENT);
        }
    }
    {
        LAS float* scr = (LAS float*)(L + 49152 + wid * 8448);
        const int gw = blockIdx.x * 8 + wid, NGW = gridDim.x * 8;
        constexpr int NITEMS = 4 * 96 * 2 * 16 + 2 * 4 * 8 * 32 + 4 * 16 * 32 + 8 * 32 * 4 + 8 * 2 * 2;
        int it = gw, istride = NGW, iend = NITEMS;
        if (gridDim.x == 256) {
            if (blockIdx.x < 192) { istride = 1536; iend = 11520; } else { it = 11520 + ((int)blockIdx.x - 192) * 8 + wid; istride = 512; }
        }
        if (it < iend) {
            TItem cur = titem_decode(a, ws, it); float tva[32]; titem_load(cur, tva, lane);
            for (;;) {
                const int nit = it + istride; const bool more = nit < iend;
                TItem nxt = cur; float tvb[32];
                if (more) { nxt = titem_decode(a, ws, nit); titem_load(nxt, tvb, lane); }
                titem_finish(cur, tva, scr, lane);
                if (!more) break;
                cur = nxt; it = nit;
#pragma unroll
                for (int i = 0; i < 32; ++i) tva[i] = tvb[i];
            }
        }
    }
    {
        f32x2* rope = (f32x2*)(ws + WS_ROPE);
        for (int e = blockIdx.x * 512 + tid; e < 2048 * 32; e += gridDim.x * 512) {
            const int t = e >> 5, i = e & 31;
            double fr = 1.0; for (int k = 0; k < i; ++k) fr *= 0.7498942093324559;
            const float freq = (float)fr; const float ang = (float)t * freq;
            const double x = (double)ang; const double kq = __builtin_rint(x * 0.15915494309189535); const double rr = x - kq * 6.283185307179586;
            const double y = 0.5 * rr, y2 = y * y;
            double sp = 2.8114572543455206e-15; sp = sp * y2 - 7.647163731819816e-13; sp = sp * y2 + 1.6059043836821613e-10; sp = sp * y2 - 2.505210838544172e-08; sp = sp * y2 + 2.7557319223985893e-06;
            sp = sp * y2 - 0.0001984126984126984; sp = sp * y2 + 0.008333333333333333; sp = sp * y2 - 0.16666666666666666; sp = sp * y2 + 1.0; const double s = sp * y;
            double cp = 1.5619206968586225e-16; cp = cp * y2 - 4.779477332387385e-14; cp = cp * y2 + 1.1470745597729725e-11; cp = cp * y2 - 2.08767569878681e-09; cp = cp * y2 + 2.755731922398589e-07;
            cp = cp * y2 - 2.48015873015873e-05; cp = cp * y2 + 0.001388888888888889; cp = cp * y2 - 0.041666666666666664; cp = cp * y2 + 0.5; const double c = 1.0 - cp * y2;
            f32x2 o; o.x = (float)(1.0 - 2.0 * s * s); o.y = (float)(2.0 * s * c); rope[e] = o;
        }
    }
}

__device__ __forceinline__ void phase1(const Args& a, unsigned char* ws, const float* xin, int l, int lane, int row_first, int row_step, int row_end) {
    const float* g = a.in[4] + l * 1024; const float* mod = (const float*)(ws + WS_MOD) + (size_t)l * 8 * 3072; bf16_t* H = (bf16_t*)(ws + WS_H);
    for (int row0 = row_first; row0 < row_end; row0 += 4 * row_step) {
        f32x4 v[4][4]; float ss[4];
#pragma unroll
        for (int q = 0; q < 4; ++q) { const f32x4* xr = (const f32x4*)(xin + (size_t)(row0 + q * row_step) * 1024) + lane;
#pragma unroll
            for (int j = 0; j < 4; ++j) v[q][j] = xr[64 * j]; }
#pragma unroll
        for (int q = 0; q < 4; ++q) { float sq = 0.f;
#pragma unroll
            for (int j = 0; j < 4; ++j) sq += (v[q][j].x * v[q][j].x + v[q][j].y * v[q][j].y) + (v[q][j].z * v[q][j].z + v[q][j].w * v[q][j].w);
            ss[q] = 1.0f / sqrtf(wave_sum(sq) * (1.0f / 1024.0f) + RMS_EPS); }
#pragma unroll
        for (int j = 0; j < 4; ++j) { const int k = 256 * j + 4 * lane; const f32x4 gg = *(const f32x4*)(g + k);
#pragma unroll
            for (int q = 0; q < 4; ++q) { const int row = row0 + q * row_step; const float* mb = mod + (size_t)(row >> 11) * 3072;
                const f32x4 sh = *(const f32x4*)(mb + k), scl = *(const f32x4*)(mb + 1024 + k); const f32x4 y = (v[q][j] * ss[q]) * gg * (scl + 1.0f) + sh;
                u32x2 w; w.x = pk2(y.x, y.y); w.y = pk2(y.z, y.w); ((u32x2*)(H + (size_t)row * 1024) + lane)[64 * j] = w; } }
    }
}

__device__ __forceinline__ bf16_t* hm_base(unsigned char* ws, size_t off, int b, int nh, int head) { return (bf16_t*)(ws + off) + ((size_t)(b * (nh - 1) + head)) * 2048 * 64; }
struct EpiIn {
    static constexpr bool PERM = true, AFTER_DRAIN = false, KEEP = false, INIT = false;
    unsigned char* ws; const float* qg; const float* ksg; const float* kwg;
    __device__ __forceinline__ void operator()(const pg8::f32x4 (&acc)[2][2][4][2], const pg8::Unit& u, int wr, int wc, int fr, int fq) const {
        const int H = u.pn * 4 + wc;
        if (H >= 93) return;
        const int b = u.pm >> 3; const int rowb = u.pm * 256 + wr * 64 + fr;
        if (H == 92) {
            float* ng = (float*)(ws + WS_NG);
            if (fq < 3) {
#pragma unroll
                for (int ai = 0; ai < 2; ++ai)
#pragma unroll
                    for (int m = 0; m < 4; ++m) { const int r = rowb + 128 * ai + 16 * m;
#pragma unroll
                        for (int n = 0; n < 2; ++n) { const pg8::f32x4 v = acc[ai][0][m][n]; f32x4 o; o.x = sigmoidf_(v[0]); o.y = sigmoidf_(v[1]); o.z = sigmoidf_(v[2]); o.w = sigmoidf_(v[3]);
                            *(f32x4*)(ng + (size_t)r * 24 + 8 * fq + 4 * n) = o; } }
            }
            return;
        }
        bf16_t* base; int ld = 64, act = 0; const float* g = nullptr; bool klay = false, clay = false;
        if (H < 8) { base = hm_base(ws, WS_SBQ, b, 8, H); act = 3; }
        else if (H < 16) { base = hm_base(ws, WS_SBK, b, 8, H - 8); klay = true; }
        else if (H < 24) base = hm_base(ws, WS_SBV, b, 8, H - 16);
        else if (H < 32) { base = (bf16_t*)(ws + WS_SBZ) + (H - 24) * 64; ld = 512; act = 1; }
        else if (H < 40) { base = hm_base(ws, WS_NQ, b, 8, H - 32); act = 3; g = qg; }
        else if (H < 42) { base = hm_base(ws, WS_KCR, b, 2, H - 40); clay = true; }
        else if (H < 44) { base = hm_base(ws, WS_VCR, b, 2, H - 42); clay = true; }
        else if (H < 46) { base = hm_base(ws, WS_KS, b, 2, H - 44); g = ksg; }
        else if (H < 48) base = hm_base(ws, WS_VS, b, 2, H - 46);
        else if (H < 50) { base = hm_base(ws, WS_KW, b, 2, H - 48); g = kwg; }
        else if (H < 52) base = hm_base(ws, WS_VW, b, 2, H - 50);
        else if (H < 60) { base = (bf16_t*)(ws + WS_NZ) + (H - 52) * 64; ld = 512; act = 1; }
        else if (H < 76) { base = (bf16_t*)(ws + WS_MA) + (H - 60) * 64; ld = 1024; act = 2; }
        else { base = (bf16_t*)(ws + WS_MB) + (H - 76) * 64; ld = 1024; act = 2; }
        const f32x2* rope = (const f32x2*)(ws + WS_ROPE);
#pragma unroll
        for (int ai = 0; ai < 2; ++ai)
#pragma unroll
            for (int m = 0; m < 4; ++m) {
                const int r = rowb + 128 * ai + 16 * m;
                float v[16];
#pragma unroll
                for (int bj = 0; bj < 2; ++bj)
#pragma unroll
                    for (int n = 0; n < 2; ++n)
#pragma unroll
                        for (int j = 0; j < 4; ++j) v[bj * 8 + n * 4 + j] = acc[ai][bj][m][n][j];
                if (g) {
                    float ss = 0.f;
#pragma unroll
                    for (int i = 0; i < 16; ++i) ss += v[i] * v[i];
                    ss += __shfl_xor(ss, 16); ss += __shfl_xor(ss, 32);
                    const float rstd = 1.0f / sqrtf(ss * (1.0f / 64.0f) + RMS_EPS);
                    const f32x2* rp = rope + (size_t)(r & 2047) * 32 + 8 * fq;
#pragma unroll
                    for (int i = 0; i < 8; ++i) { const float x1 = v[i] * rstd * g[8 * fq + i], x2 = v[8 + i] * rstd * g[32 + 8 * fq + i]; const f32x2 cs = rp[i];
                        v[i] = x1 * cs.x - x2 * cs.y; v[8 + i] = x2 * cs.x + x1 * cs.y; }
                }
                if (act == 1) {
#pragma unroll
                    for (int i = 0; i < 16; ++i) v[i] = siluf_(v[i]);
                } else if (act == 2) {
#pragma unroll
                    for (int i = 0; i < 16; ++i) v[i] = sigmoidf_(v[i]);
                } else if (act == 3) {
#pragma unroll
                    for (int i = 0; i < 16; ++i) v[i] *= QSCALE;
                }
                bf16_t* rowp = base + (size_t)r * ld + 8 * fq;
                if (klay) { const int s_ = r & 2047;
                    rowp = base + (size_t)(r - s_) * 64 + (size_t)(s_ >> 6) * 4096 + ((((fq >> 1) * 2 + ((s_ >> 5) & 1)) * 32 + (s_ & 31)) * 2 + (fq & 1)) * 8; }
                u32x4 w0, w1; w0.x = pk2(v[0], v[1]); w0.y = pk2(v[2], v[3]); w0.z = pk2(v[4], v[5]); w0.w = pk2(v[6], v[7]);
                w1.x = pk2(v[8], v[9]); w1.y = pk2(v[10], v[11]); w1.z = pk2(v[12], v[13]); w1.w = pk2(v[14], v[15]);
                if (clay) { const int s_ = r & 2047; rowp = base + (size_t)(r - s_) * 64 + (size_t)((s_ & 15) * 128 + (s_ >> 4)) * 32 + 8 * fq; }
                st16_wt(rowp, w0); st16_wt(rowp + (klay ? 2048 : (clay ? 65536 : 32)), w1);
            }
    }
};
template <int MODE  > struct EpiOut {
    static constexpr bool PERM = false, AFTER_DRAIN = false, KEEP = false, INIT = false;
    unsigned char* ws; const float* xin; float* out; const float* gate;
    __device__ __forceinline__ void operator()(const pg8::f32x4 (&acc)[2][2][4][2], const pg8::Unit& u, int wr, int wc, int fr, int fq) const {
        const int rowb = u.pm * 256 + wr * 64 + fr, colb = u.pn * 256 + wc * 32 + 4 * fq; const int b = u.pm >> 3;
#pragma unroll
        for (int ai = 0; ai < 2; ++ai)
#pragma unroll
            for (int m = 0; m < 4; ++m) { const size_t r = rowb + 128 * ai + 16 * m;
#pragma unroll
                for (int bj = 0; bj < 2; ++bj)
#pragma unroll
                    for (int n = 0; n < 2; ++n) { const int c = colb + 128 * bj + 16 * n; const pg8::f32x4 v = acc[ai][bj][m][n];
                        if (MODE == 0) { const u32x2 mw = *(const u32x2*)((const bf16_t*)(ws + WS_MA) + r * 1024 + c);
                            u32x2 o; o.x = pk2(v[0] * bf_lo(mw.x), v[1] * bf_hi(mw.x)); o.y = pk2(v[2] * bf_lo(mw.y), v[3] * bf_hi(mw.y)); *(u32x2*)((bf16_t*)(ws + WS_YA) + r * 1024 + c) = o; }
                        else if (MODE == 1) { const u32x2 mw = *(const u32x2*)((const bf16_t*)(ws + WS_MB) + r * 1024 + c); const u32x2 ya = *(const u32x2*)((const bf16_t*)(ws + WS_YA) + r * 1024 + c);
                            u32x2 o; o.x = pk2(bf_lo(ya.x) + v[0] * bf_lo(mw.x), bf_hi(ya.x) + v[1] * bf_hi(mw.x)); o.y = pk2(bf_lo(ya.y) + v[2] * bf_lo(mw.y), bf_hi(ya.y) + v[3] * bf_hi(mw.y)); st8_wt((bf16_t*)(ws + WS_Y) + r * 1024 + c, o); }
                        else { const f32x4 xv = *(const f32x4*)(xin + r * 1024 + c), gv = *(const f32x4*)(gate + (size_t)b * 3072 + c);
                            f32x4 o; o.x = xv.x + gv.x * v[0]; o.y = xv.y + gv.y * v[1]; o.z = xv.z + gv.z * v[2]; o.w = xv.w + gv.w * v[3]; st16_wt(out + r * 1024 + c, __builtin_bit_cast(u32x4, o)); } }
            }
    }
};

struct EpiOutNorm {
    static constexpr bool PERM = true, AFTER_DRAIN = true, KEEP = false, INIT = true;
    unsigned char* ws; const float* xin; float* out; const float* gate; const float* gnext; const float* modnext; unsigned* cnt; int fuse;
    static __device__ __forceinline__ float gate_c(float g) { return __builtin_fabsf(g) < 8.673617e-19f ? __builtin_copysignf(8.673617e-19f, g) : g; }
    __device__ __forceinline__ void init_load(pg8::f32x4 (&acc)[2][2][4][2], const pg8::Unit& u, int wr, int wc, int fr, int fq) const {
        const int rowb = u.pm * 256 + wr * 64 + fr, colb = u.pn * 256 + wc * 32 + 8 * fq;
#pragma unroll
        for (int ai = 0; ai < 2; ++ai)
#pragma unroll
            for (int m = 0; m < 4; ++m) { const size_t r = rowb + 128 * ai + 16 * m;
#pragma unroll
                for (int bj = 0; bj < 2; ++bj)
#pragma unroll
                    for (int n = 0; n < 2; ++n) { const f32x4 xv = *(const f32x4*)(xin + r * 1024 + colb + 128 * bj + 4 * n); pg8::f32x4& v = acc[ai][bj][m][n]; v[0] = xv.x; v[1] = xv.y; v[2] = xv.z; v[3] = xv.w; } }
    }
    __device__ __forceinline__ void init_scale(pg8::f32x4 (&acc)[2][2][4][2], const pg8::Unit& u, int wr, int wc, int fr, int fq) const {
        const int colb = u.pn * 256 + wc * 32 + 8 * fq; const int b = u.pm >> 3;
#pragma unroll
        for (int bj = 0; bj < 2; ++bj)
#pragma unroll
            for (int n = 0; n < 2; ++n) { const f32x4 gv = *(const f32x4*)(gate + (size_t)b * 3072 + colb + 128 * bj + 4 * n);
                const float r0 = __builtin_amdgcn_rcpf(gate_c(gv.x)), r1 = __builtin_amdgcn_rcpf(gate_c(gv.y)), r2 = __builtin_amdgcn_rcpf(gate_c(gv.z)), r3 = __builtin_amdgcn_rcpf(gate_c(gv.w));
#pragma unroll
                for (int ai = 0; ai < 2; ++ai)
#pragma unroll
                    for (int m = 0; m < 4; ++m) { pg8::f32x4& v = acc[ai][bj][m][n]; v[0] *= r0; v[1] *= r1; v[2] *= r2; v[3] *= r3; } }
    }
    __device__ __forceinline__ void fused(pg8::f32x4 (&acc)[2][2][4][2], const pg8::Unit& u, int wr, int wc, int fr, int fq, PG8_LAS unsigned char* lds, int wid, int lane) const {
        const int rowb = u.pm * 256 + wr * 64 + fr, colb = u.pn * 256 + wc * 32 + 8 * fq; const int b = u.pm >> 3;
        float* ssq = (float*)(ws + WS_SSQ);
#pragma unroll
        for (int ai = 0; ai < 2; ++ai)
#pragma unroll
            for (int m = 0; m < 4; ++m) { const size_t r = rowb + 128 * ai + 16 * m; float sq = 0.f;
#pragma unroll
                for (int bj = 0; bj < 2; ++bj)
#pragma unroll
                    for (int n = 0; n < 2; ++n) { const int c = colb + 128 * bj + 4 * n; const f32x4 gv = *(const f32x4*)(gate + (size_t)b * 3072 + c);
                        pg8::f32x4& v = acc[ai][bj][m][n]; v[0] = gate_c(gv.x) * v[0]; v[1] = gate_c(gv.y) * v[1]; v[2] = gate_c(gv.z) * v[2]; v[3] = gate_c(gv.w) * v[3];
                        f32x4 o; o.x = v[0]; o.y = v[1]; o.z = v[2]; o.w = v[3]; *(f32x4*)(out + r * 1024 + c) = o;
                        sq += (v[0] * v[0] + v[1] * v[1]) + (v[2] * v[2] + v[3] * v[3]); }
                if (fuse) { sq += __shfl_xor(sq, 16); sq += __shfl_xor(sq, 32); if (fq == 0) __hip_atomic_store(ssq + r * 16 + u.pn * 4 + wc, sq, __ATOMIC_RELAXED, __HIP_MEMORY_SCOPE_AGENT); }
            }
        if (!fuse) return;
        asm volatile("s_waitcnt vmcnt(0)" ::: "memory");
        __builtin_amdgcn_s_barrier(); asm volatile("" ::: "memory");
        if (wid == 0 && lane == 0) {
            unsigned* c = cnt + u.pm; unsigned sp = 0;
            __hip_atomic_fetch_add(c, 1u, __ATOMIC_RELAXED, __HIP_MEMORY_SCOPE_AGENT);
            while (__hip_atomic_load(c, __ATOMIC_RELAXED, __HIP_MEMORY_SCOPE_AGENT) < 4u) { __builtin_amdgcn_s_sleep(1); if (++sp > (1u << 22)) break; }
        }
        asm volatile("" ::: "memory"); __builtin_amdgcn_s_barrier(); asm volatile("" ::: "memory");
        PG8_LAS float* S = (PG8_LAS float*)lds;
        { const int t = wid * 64 + lane;
          if (t < 256) { float* pp = ssq + (size_t)(u.pm * 256 + t) * 16; float pv_[16];
#pragma unroll
              for (int q = 0; q < 16; ++q) pv_[q] = __hip_atomic_load(pp + q, __ATOMIC_RELAXED, __HIP_MEMORY_SCOPE_AGENT);
              const float tot = (((pv_[0] + pv_[1]) + (pv_[2] + pv_[3])) + ((pv_[4] + pv_[5]) + (pv_[6] + pv_[7]))) + (((pv_[8] + pv_[9]) + (pv_[10] + pv_[11])) + ((pv_[12] + pv_[13]) + (pv_[14] + pv_[15])));
              S[t] = 1.0f / sqrtf(tot * (1.0f / 1024.0f) + RMS_EPS); } }
        asm volatile("s_waitcnt lgkmcnt(0)" ::: "memory"); __builtin_amdgcn_s_barrier(); asm volatile("" ::: "memory");
        bf16_t* H = (bf16_t*)(ws + WS_H); const float* mb = modnext + (size_t)b * 3072;
#pragma unroll
        for (int bj = 0; bj < 2; ++bj) { const int c = colb + 128 * bj;
            const f32x4 g0 = *(const f32x4*)(gnext + c), g1 = *(const f32x4*)(gnext + c + 4), s0 = *(const f32x4*)(mb + c), s1 = *(const f32x4*)(mb + c + 4), q0 = *(const f32x4*)(mb + 1024 + c), q1 = *(const f32x4*)(mb + 1024 + c + 4);
            const f32x4 m0 = g0 * (q0 + 1.0f), m1 = g1 * (q1 + 1.0f);
#pragma unroll
            for (int ai = 0; ai < 2; ++ai)
#pragma unroll
                for (int m = 0; m < 4; ++m) { const int rl = 128 * ai + wr * 64 + 16 * m + fr; const float rs = S[rl]; const size_t r = (size_t)u.pm * 256 + rl;
                    const pg8::f32x4 v0 = acc[ai][bj][m][0], v1 = acc[ai][bj][m][1];
                    u32x4 w; w.x = pk2(v0[0] * rs * m0.x + s0.x, v0[1] * rs * m0.y + s0.y); w.y = pk2(v0[2] * rs * m0.z + s0.z, v0[3] * rs * m0.w + s0.w);
                    w.z = pk2(v1[0] * rs * m1.x + s1.x, v1[1] * rs * m1.y + s1.y); w.w = pk2(v1[2] * rs * m1.z + s1.z, v1[3] * rs * m1.w + s1.w);
                    *(u32x4*)(H + r * 1024 + c) = w; }
        }
    }
};
struct OrderAB {
    pg8::StaticOrder base;
    __device__ __forceinline__ bool next(int i, pg8::Unit& u) const { if (!base.next(i >> 1, u)) return false; if (i & 1) { u.pm += 64; u.pn += 4; } return true; }
    __device__ __forceinline__ void a_ready(const pg8::Unit&) const {}
    __device__ __forceinline__ void done(const pg8::Unit&) const {}
};
struct EpiAB {
    static constexpr bool PERM = true, AFTER_DRAIN = false, KEEP = true, INIT = false;
    unsigned char* ws;
    __device__ __forceinline__ bool keep(const pg8::Unit& u) const { return u.pm < 64; }
    __device__ __forceinline__ void operator()(pg8::f32x4 (&acc)[2][2][4][2], const pg8::Unit& u, int wr, int wc, int fr, int fq) const {
        const bool second = u.pm >= 64; const int pm = second ? u.pm - 64 : u.pm, pn = second ? u.pn - 4 : u.pn;
        const int rowb = pm * 256 + wr * 64 + fr, colb = pn * 256 + wc * 32 + 8 * fq;
        const bf16_t* map = (const bf16_t*)(ws + WS_MA); const bf16_t* mbp = (const bf16_t*)(ws + WS_MB);
#pragma unroll
        for (int ai = 0; ai < 2; ++ai)
#pragma unroll
            for (int m = 0; m < 4; ++m) { const size_t r = rowb + 128 * ai + 16 * m;
#pragma unroll
                for (int bj = 0; bj < 2; ++bj) { const int c = colb + 128 * bj;
                    const u32x4 bw = *(const u32x4*)(mbp + r * 1024 + c);
                    float gb[8]; gb[0] = bf_lo(bw.x); gb[1] = bf_hi(bw.x); gb[2] = bf_lo(bw.y); gb[3] = bf_hi(bw.y); gb[4] = bf_lo(bw.z); gb[5] = bf_hi(bw.z); gb[6] = bf_lo(bw.w); gb[7] = bf_hi(bw.w);
#pragma unroll
                    for (int i = 0; i < 8; ++i) gb[i] = fmaxf(gb[i], 8.673617e-19f);
                    pg8::f32x4& v0 = acc[ai][bj][m][0]; pg8::f32x4& v1 = acc[ai][bj][m][1];
                    if (!second) { const u32x4 aw = *(const u32x4*)(map + r * 1024 + c);
                        v0[0] = v0[0] * bf_lo(aw.x) * __builtin_amdgcn_rcpf(gb[0]); v0[1] = v0[1] * bf_hi(aw.x) * __builtin_amdgcn_rcpf(gb[1]); v0[2] = v0[2] * bf_lo(aw.y) * __builtin_amdgcn_rcpf(gb[2]); v0[3] = v0[3] * bf_hi(aw.y) * __builtin_amdgcn_rcpf(gb[3]);
                        v1[0] = v1[0] * bf_lo(aw.z) * __builtin_amdgcn_rcpf(gb[4]); v1[1] = v1[1] * bf_hi(aw.z) * __builtin_amdgcn_rcpf(gb[5]); v1[2] = v1[2] * bf_lo(aw.w) * __builtin_amdgcn_rcpf(gb[6]); v1[3] = v1[3] * bf_hi(aw.w) * __builtin_amdgcn_rcpf(gb[7]);
                    } else {
                        u32x4 o; o.x = pk2(v0[0] * gb[0], v0[1] * gb[1]); o.y = pk2(v0[2] * gb[2], v0[3] * gb[3]); o.z = pk2(v1[0] * gb[4], v1[1] * gb[5]); o.w = pk2(v1[2] * gb[6], v1[3] * gb[7]);
                        *(u32x4*)((bf16_t*)(ws + WS_Y) + r * 1024 + c) = o; }
                }
            }
    }
};

constexpr int TROW = 144, TILEB = 64 * TROW;
__device__ __forceinline__ int kvl_of(int v, int r, int hi) { return 32 * v + 8 * (r >> 2) + 4 * hi + (r & 3); }
__device__ __forceinline__ constexpr int kvc(int v, int r) { return 32 * v + 8 * (r >> 2) + (r & 3); }
__device__ __forceinline__ void qk_tile(f32x16& p0, f32x16& p1, const LAS unsigned char* K, const bf16x8 (&qf)[4], int r32, int hi) {
    const LAS unsigned char* kb = K + r32 * TROW + hi * 16;
    f32x16 z = {0.f, 0.f, 0.f, 0.f, 0.f, 0.f, 0.f, 0.f, 0.f, 0.f, 0.f, 0.f, 0.f, 0.f, 0.f, 0.f};
    p0 = z; p1 = z;
    bf16x8 a[8];
#pragma unroll
    for (int d0 = 0; d0 < 4; ++d0) { a[2 * d0] = *(const LAS bf16x8*)(kb + d0 * 32); a[2 * d0 + 1] = *(const LAS bf16x8*)(kb + 32 * TROW + d0 * 32); }
    __builtin_amdgcn_sched_barrier(0);
#pragma unroll
    for (int d0 = 0; d0 < 4; ++d0) {
        p0 = __builtin_amdgcn_mfma_f32_32x32x16_bf16(a[2 * d0], qf[d0], p0, 0, 0, 0);
        p1 = __builtin_amdgcn_mfma_f32_32x32x16_bf16(a[2 * d0 + 1], qf[d0], p1, 0, 0, 0);
    }
}
__device__ __forceinline__ s16x4 vtr(const LAS unsigned char* p) { return __builtin_bit_cast(s16x4, __builtin_amdgcn_ds_read_tr16_b64_v4i16((LAS s16x4*)p)); }
__device__ __forceinline__ void pv_tile(f32x16 (&o)[2], const LAS unsigned char* V, const f32x16& e0, const f32x16& e1, int lane) {
    const int hi = lane >> 5;
    const LAS unsigned char* vb = V + (4 * hi + ((lane & 15) >> 2)) * TROW + (16 * ((lane >> 4) & 1) + 4 * (lane & 3)) * 2;
    s16x4 lo[4][2], hh[4][2];
#pragma unroll
    for (int ks = 0; ks < 4; ++ks)
#pragma unroll
        for (int dt = 0; dt < 2; ++dt) { lo[ks][dt] = vtr(vb + ks * 16 * TROW + dt * 64); hh[ks][dt] = vtr(vb + (ks * 16 + 8) * TROW + dt * 64); }
    u32x4 pw[4];
    pw[0].x = pk2(e0[0], e0[1]); pw[0].y = pk2(e0[2], e0[3]); pw[0].z = pk2(e0[4], e0[5]); pw[0].w = pk2(e0[6], e0[7]);
    pw[1].x = pk2(e0[8], e0[9]); pw[1].y = pk2(e0[10], e0[11]); pw[1].z = pk2(e0[12], e0[13]); pw[1].w = pk2(e0[14], e0[15]);
    pw[2].x = pk2(e1[0], e1[1]); pw[2].y = pk2(e1[2], e1[3]); pw[2].z = pk2(e1[4], e1[5]); pw[2].w = pk2(e1[6], e1[7]);
    pw[3].x = pk2(e1[8], e1[9]); pw[3].y = pk2(e1[10], e1[11]); pw[3].z = pk2(e1[12], e1[13]); pw[3].w = pk2(e1[14], e1[15]);
    __builtin_amdgcn_sched_barrier(0);
#pragma unroll
    for (int ks = 0; ks < 4; ++ks) {
        const bf16x8 pb = __builtin_bit_cast(bf16x8, pw[ks]);
#pragma unroll
        for (int dt = 0; dt < 2; ++dt) {
            const bf16x8 va = {lo[ks][dt][0], lo[ks][dt][1], lo[ks][dt][2], lo[ks][dt][3], hh[ks][dt][0], hh[ks][dt][1], hh[ks][dt][2], hh[ks][dt][3]};
            o[dt] = __builtin_amdgcn_mfma_f32_32x32x16_bf16(va, pb, o[dt], 0, 0, 0);
        }
    }
}
#define F16ZERO (f32x16){0.f, 0.f, 0.f, 0.f, 0.f, 0.f, 0.f, 0.f, 0.f, 0.f, 0.f, 0.f, 0.f, 0.f, 0.f, 0.f}

constexpr int OSTG = 272;
__device__ __forceinline__ void attn_rows_out(const f32x16 (&o)[2], LAS unsigned char* stg, const bf16_t* zbase, bf16_t* obase, int lane) {
    const int r32 = lane & 31, hi = lane >> 5;
#pragma unroll
    for (int dt = 0; dt < 2; ++dt)
#pragma unroll
        for (int c4 = 0; c4 < 4; ++c4) { f32x4 v; v.x = o[dt][4 * c4]; v.y = o[dt][4 * c4 + 1]; v.z = o[dt][4 * c4 + 2]; v.w = o[dt][4 * c4 + 3];
            *(LAS f32x4*)(stg + r32 * OSTG + (32 * dt + 8 * c4 + 4 * hi) * 4) = v; }
#pragma unroll
    for (int i = 0; i < 4; ++i) { const int row = 8 * i + (lane >> 3), ch = lane & 7;
        const f32x4 a0 = *(const LAS f32x4*)(stg + row * OSTG + ch * 32), a1 = *(const LAS f32x4*)(stg + row * OSTG + ch * 32 + 16);
        const u32x4 zw = *(const u32x4*)(zbase + (size_t)row * 512 + ch * 8);
        u32x4 w; w.x = pk2(a0.x * bf_lo(zw.x), a0.y * bf_hi(zw.x)); w.y = pk2(a0.z * bf_lo(zw.y), a0.w * bf_hi(zw.y)); w.z = pk2(a1.x * bf_lo(zw.z), a1.y * bf_hi(zw.z)); w.w = pk2(a1.z * bf_lo(zw.w), a1.w * bf_hi(zw.w));
        *(u32x4*)(obase + (size_t)row * 512 + ch * 8) = w; }
}

__device__ __forceinline__ void sb_wave_unit(unsigned char* ws, LAS unsigned char* Lw, int b, int h, int qt, int lane) {
    const int r32 = lane & 31, hi = lane >> 5;
    const int tw0 = qt * 32, t = tw0 + r32;
    const bf16_t* Qp = (const bf16_t*)(ws + WS_SBQ) + ((size_t)(b * 8 + h) * 2048) * 64;
    const bf16_t* Kp = (const bf16_t*)(ws + WS_SBK) + ((size_t)(b * 8 + h) * 2048) * 64;
    const bf16_t* Vp = (const bf16_t*)(ws + WS_SBV) + ((size_t)(b * 8 + h) * 2048) * 64;
    bf16x8 qf[4];
#pragma unroll
    for (int d0 = 0; d0 < 4; ++d0) qf[d0] = *(const bf16x8*)(Qp + (size_t)t * 64 + 16 * d0 + 8 * hi);
    f32x16 o[2]; o[0] = F16ZERO; o[1] = F16ZERO;
    float carry = 1.0f;
    const int jt0 = (tw0 + 30) >> 6;
    const int kgo = (r32 * 2 + hi) * 8;
    const int vgo = (lane >> 3) * 64 + (lane & 7) * 8, vlo = (lane >> 3) * TROW + (lane & 7) * 16;
    bf16x8 kn[8];
#pragma unroll
    for (int f = 0; f < 8; ++f) kn[f] = *(const bf16x8*)(Kp + (size_t)jt0 * 4096 + kgo + 512 * f);
    for (int jt = jt0; jt >= 0; --jt) {
        const int kb = 64 * jt;
        u32x4 vr[8];
#pragma unroll
        for (int i = 0; i < 8; ++i) vr[i] = *(const u32x4*)(Vp + (size_t)jt * 4096 + i * 512 + vgo);
        bf16x8 kc[8];
#pragma unroll
        for (int i = 0; i < 8; ++i) kc[i] = kn[i];
        if (jt > 0) {
#pragma unroll
            for (int f = 0; f < 8; ++f) kn[f] = *(const bf16x8*)(Kp + (size_t)(jt - 1) * 4096 + kgo + 512 * f);
        }
        f32x16 p0 = F16ZERO, p1 = F16ZERO;
#pragma unroll
        for (int d0 = 0; d0 < 4; ++d0) { p0 = __builtin_amdgcn_mfma_f32_32x32x16_bf16(kc[2 * d0], qf[d0], p0, 0, 0, 0); p1 = __builtin_amdgcn_mfma_f32_32x32x16_bf16(kc[2 * d0 + 1], qf[d0], p1, 0, 0, 0); }
        f32x16 k0, k1; const int lim = t - kb - 4 * hi;
        const bool full = (kb + 63 < tw0);
#pragma unroll
        for (int r = 0; r < 16; ++r) {
            { float sg = __builtin_amdgcn_rcpf(1.0f + __builtin_amdgcn_exp2f(-p0[r]));
              if (!full) sg = (kvc(0, r) < lim) ? sg : 0.f; p0[r] = sg; k0[r] = 1.0f - sg; }
            { float sg = __builtin_amdgcn_rcpf(1.0f + __builtin_amdgcn_exp2f(-p1[r]));
              if (!full) sg = (kvc(1, r) < lim) ? sg : 0.f; p1[r] = sg; k1[r] = 1.0f - sg; }
        }
        float T[8], Tp[8], U[8], R[8];
#pragma unroll
        for (int c = 0; c < 8; ++c) {
            float x0, x1, x2, x3;
            if (c < 4) { x0 = k0[4 * c]; x1 = k0[4 * c + 1]; x2 = k0[4 * c + 2]; x3 = k0[4 * c + 3]; } else { x0 = k1[4 * c - 16]; x1 = k1[4 * c - 15]; x2 = k1[4 * c - 14]; x3 = k1[4 * c - 13]; }
            const float s2 = x3, s1 = x3 * x2, s0 = s1 * x1; T[c] = s0 * x0;
            if (c < 4) { k0[4 * c] = s0; k0[4 * c + 1] = s1; k0[4 * c + 2] = s2; k0[4 * c + 3] = 1.0f; } else { k1[4 * c - 16] = s0; k1[4 * c - 15] = s1; k1[4 * c - 14] = s2; k1[4 * c - 13] = 1.0f; }
        }
#pragma unroll
        for (int c = 0; c < 8; ++c) { Tp[c] = __shfl_xor(T[c], 32); U[c] = T[c] * Tp[c]; }
        R[7] = 1.0f;
#pragma unroll
        for (int c = 6; c >= 0; --c) R[c] = R[c + 1] * U[c + 1];
#pragma unroll
        for (int c = 0; c < 8; ++c) {
            const float off = R[c] * (hi == 0 ? Tp[c] : 1.0f) * carry;
#pragma unroll
            for (int i = 0; i < 4; ++i) {
                if (c < 4) p0[4 * c + i] = p0[4 * c + i] * (k0[4 * c + i] * off);
                else p1[4 * c - 16 + i] = p1[4 * c - 16 + i] * (k1[4 * c - 16 + i] * off);
            }
        }
        carry *= R[0] * U[0];
#pragma unroll
        for (int i = 0; i < 8; ++i) *(LAS u32x4*)(Lw + i * 8 * TROW + vlo) = vr[i];
        pv_tile(o, Lw, p0, p1, lane);
        if (__all(carry < 5.421e-20f)) break;
    }
    const size_t tok0 = (size_t)b * 2048 + tw0;
    attn_rows_out(o, Lw, (const bf16_t*)(ws + WS_SBZ) + tok0 * 512 + h * 64, (bf16_t*)(ws + WS_AACT) + tok0 * 512 + h * 64, lane);
}

typedef float f32x4v __attribute__((ext_vector_type(4)));
__device__ __forceinline__ void cmp_unit(const Args& a, unsigned char* ws, LAS unsigned char* L, int l, int u, int tid, int lane, int wid) {
    const int nt = u & 7, g = (u >> 3) & 1, b = (u >> 4) & 7, kv = u >> 7;
    const int c16 = lane & 15, kq = lane >> 4;
    const bf16_t* src = (const bf16_t*)(ws + (kv ? WS_VCR : WS_KCR)) + ((size_t)(b * 2 + g) * 2048) * 64;
    const bf16_t* W1T = (const bf16_t*)(ws + WS_W1T) + (size_t)(l * 2 + kv) * 128 * 2048;
    const bf16_t* W2T = (const bf16_t*)(ws + WS_W2T) + (size_t)(l * 2 + kv) * 64 * 128;
    const float* b1v = (const float*)(ws + WS_B1) + (size_t)(l * 2 + kv) * 128;
    LAS float* red = (LAS float*)L; LAS bf16_t* hid = (LAS bf16_t*)(L + 32768); LAS float* kraw = (LAS float*)(L + 41472);
    const int j = wid & 1, kh = wid >> 1;
    f32x4v acc0 = {0.f, 0.f, 0.f, 0.f}, acc1 = {0.f, 0.f, 0.f, 0.f}, acc2 = {0.f, 0.f, 0.f, 0.f}, acc3 = {0.f, 0.f, 0.f, 0.f};
    const bf16_t* ap = src + (size_t)(16 * nt + c16 + (kh >> 1) + (kh & 1) * 1024) * 32 + 8 * kq;     const bf16_t* bp = W1T + (size_t)j * 131072 + kh * 8192 + lane * 8;
#pragma unroll 8
    for (int kk = 0; kk < 16; ++kk) {
        const bf16x8 af = *(const bf16x8*)(ap + (kk >> 1) * 4096 + (kk & 1) * 65536);
        const bf16x8 b0 = *(const bf16x8*)(bp + 512 * kk), b1 = *(const bf16x8*)(bp + 32768 + 512 * kk), b2 = *(const bf16x8*)(bp + 65536 + 512 * kk), b3 = *(const bf16x8*)(bp + 98304 + 512 * kk);
        acc0 = __builtin_amdgcn_mfma_f32_16x16x32_bf16(af, b0, acc0, 0, 0, 0);
        acc1 = __builtin_amdgcn_mfma_f32_16x16x32_bf16(af, b1, acc1, 0, 0, 0);
        acc2 = __builtin_amdgcn_mfma_f32_16x16x32_bf16(af, b2, acc2, 0, 0, 0);
        acc3 = __builtin_amdgcn_mfma_f32_16x16x32_bf16(af, b3, acc3, 0, 0, 0);
    }
    __syncthreads();
#pragma unroll
    for (int i = 0; i < 4; ++i) { LAS float* rr = red + (kh * 16 + 4 * kq + i) * 128 + 64 * j + c16; rr[0] = acc0[i]; rr[16] = acc1[i]; rr[32] = acc2[i]; rr[48] = acc3[i]; }
    __syncthreads();
    for (int e = tid; e < 16 * 128; e += 512) { const int row = e >> 7, col = e & 127; const float v = ((red[row * 128 + col] + red[(16 + row) * 128 + col]) + (red[(32 + row) * 128 + col] + red[(48 + row) * 128 + col])) + b1v[col]; hid[row * 136 + col] = (bf16_t)f2bf(siluf_(v)); }
    __syncthreads();
    if (wid < 4) {
        f32x4v o2 = {0.f, 0.f, 0.f, 0.f};
#pragma unroll
        for (int ks = 0; ks < 4; ++ks) { const bf16x8 af = *(const LAS bf16x8*)(hid + c16 * 136 + 32 * ks + 8 * kq); const bf16x8 bf = *(const bf16x8*)(W2T + (size_t)(16 * wid + c16) * 128 + 32 * ks + 8 * kq);
            o2 = __builtin_amdgcn_mfma_f32_16x16x32_bf16(af, bf, o2, 0, 0, 0); }
#pragma unroll
        for (int i = 0; i < 4; ++i) kraw[(4 * kq + i) * 65 + 16 * wid + c16] = o2[i];
    }
    __syncthreads();
    if (tid < 256) {
        const int row = tid >> 4, dl = tid & 15, n = 16 * nt + row;
        float x[4]; x[0] = kraw[row * 65 + dl]; x[1] = kraw[row * 65 + dl + 16]; x[2] = kraw[row * 65 + dl + 32]; x[3] = kraw[row * 65 + dl + 48];
        bf16_t* dst = (bf16_t*)(ws + (kv ? WS_VC : WS_KC)) + ((size_t)(b * 2 + g) * 128 + n) * 64;
        if (kv == 0) {
            float ss = x[0] * x[0] + x[1] * x[1] + x[2] * x[2] + x[3] * x[3];
            ss += __shfl_xor(ss, 1); ss += __shfl_xor(ss, 2); ss += __shfl_xor(ss, 4); ss += __shfl_xor(ss, 8);
            const float rstd = 1.0f / sqrtf(ss * (1.0f / 64.0f) + RMS_EPS); const float* gk = a.in[7] + l * 64;
            const int pos = (n < 127) ? 16 * n + 31 : 2047; const f32x2* rp = (const f32x2*)(ws + WS_ROPE) + (size_t)pos * 32;
#pragma unroll
            for (int q = 0; q < 2; ++q) { const int i = dl + 16 * q; const float x1 = x[q] * rstd * gk[i], x2 = x[2 + q] * rstd * gk[i + 32]; const f32x2 cs = rp[i];
                x[q] = x1 * cs.x - x2 * cs.y; x[2 + q] = x2 * cs.x + x1 * cs.y; }
        }
        if (n == 127) { x[0] = 0.f; x[1] = 0.f; x[2] = 0.f; x[3] = 0.f; }
        dst[dl] = (bf16_t)f2bf(x[0]); dst[dl + 16] = (bf16_t)f2bf(x[1]); dst[dl + 32] = (bf16_t)f2bf(x[2]); dst[dl + 48] = (bf16_t)f2bf(x[3]);
    }
}

__device__ __forceinline__ void softmax_step(f32x16& p0, f32x16& p1, float& m, float& lsum, f32x16 (&o)[2], int kb, int t, int mode, bool sel, int hi) {
    if (mode != 0 || !sel) {
        int lo = -1000000, hi_ = 1000000;
        if (mode == 1) hi_ = t - kb - 4 * hi; else if (mode == 2) lo = t - 255 - kb - 4 * hi;
        if (!sel) hi_ = -2000000;
#pragma unroll
        for (int r = 0; r < 16; ++r) {
            p0[r] = (kvc(0, r) >= lo && kvc(0, r) <= hi_) ? p0[r] : NEGF; p1[r] = (kvc(1, r) >= lo && kvc(1, r) <= hi_) ? p1[r] : NEGF;
        }
    }
    float rm = fmaxf(p0[0], p1[0]);
#pragma unroll
    for (int r = 1; r < 16; ++r) rm = fmaxf(rm, fmaxf(p0[r], p1[r]));
    rm = fmaxf(rm, __shfl_xor(rm, 32));
    const float mn = fmaxf(m, rm), alpha = __builtin_amdgcn_exp2f(m - mn);
    float ls = 0.f;
#pragma unroll
    for (int r = 0; r < 16; ++r) { p0[r] = __builtin_amdgcn_exp2f(p0[r] - mn); p1[r] = __builtin_amdgcn_exp2f(p1[r] - mn); ls += p0[r] + p1[r]; }
    lsum = lsum * alpha + ls; m = mn;
#pragma unroll
    for (int r = 0; r < 16; ++r) { o[0][r] *= alpha; o[1][r] *= alpha; }
}

__device__ __forceinline__ void qk_tile_c(f32x16& p0, f32x16& p1, const LAS unsigned char* K, const bf16x8 (&qf)[4], int r32, int hi, const f32x16& c) {
    const LAS unsigned char* kb = K + r32 * TROW + hi * 16;
    p0 = c; p1 = c;
    bf16x8 a[8];
#pragma unroll
    for (int d0 = 0; d0 < 4; ++d0) { a[2 * d0] = *(const LAS bf16x8*)(kb + d0 * 32); a[2 * d0 + 1] = *(const LAS bf16x8*)(kb + 32 * TROW + d0 * 32); }
    __builtin_amdgcn_sched_barrier(0);
#pragma unroll
    for (int d0 = 0; d0 < 4; ++d0) {
        p0 = __builtin_amdgcn_mfma_f32_32x32x16_bf16(a[2 * d0], qf[d0], p0, 0, 0, 0);
        p1 = __builtin_amdgcn_mfma_f32_32x32x16_bf16(a[2 * d0 + 1], qf[d0], p1, 0, 0, 0);
    }
}
__device__ __forceinline__ void softmax_step_lazy(f32x16& p0, f32x16& p1, float& mref, float& lsum, f32x16 (&o)[2], int kb, int t, int mode, int hi, bool first) {
    if (mode != 0) {
        int lo = -1000000, hi_ = 1000000;
        if (mode == 1) hi_ = t - kb - 4 * hi; else if (mode == 2) lo = t - 255 - kb - 4 * hi;
#pragma unroll
        for (int r = 0; r < 16; ++r) {
            p0[r] = (kvc(0, r) >= lo && kvc(0, r) <= hi_) ? p0[r] : NEGF; p1[r] = (kvc(1, r) >= lo && kvc(1, r) <= hi_) ? p1[r] : NEGF;
        }
    }
    float rm = fmaxf(p0[0], p1[0]);
#pragma unroll
    for (int r = 1; r < 16; ++r) rm = fmaxf(rm, fmaxf(p0[r], p1[r]));
    rm = fmaxf(rm, __shfl_xor(rm, 32));
    if (first || __any(rm > 8.0f)) {
        const float dl = first ? rm : fmaxf(rm, 0.f), alpha = __builtin_amdgcn_exp2f(-dl);
        mref += dl; lsum *= alpha;
#pragma unroll
        for (int r = 0; r < 16; ++r) { p0[r] -= dl; p1[r] -= dl; o[0][r] *= alpha; o[1][r] *= alpha; }
    }
    float ls = 0.f;
#pragma unroll
    for (int r = 0; r < 16; ++r) { p0[r] = __builtin_amdgcn_exp2f(p0[r]); p1[r] = __builtin_amdgcn_exp2f(p1[r]); ls += p0[r] + p1[r]; }
    lsum += ls;
}

__device__ __forceinline__ void nsa_unit(unsigned char* ws, LAS unsigned char* L, int b, int g, int cur, int tid, int lane, int wid) {
    const int r32 = lane & 31, hi = lane >> 5, hh = wid >> 1, qh = wid & 1, h = 4 * g + hh;
    const int ql = 32 * qh + r32, t = 64 * cur + ql; const size_t tok = (size_t)b * 2048 + t;
    const bf16_t* Qp = (const bf16_t*)(ws + WS_NQ) + ((size_t)(b * 8 + h) * 2048 + t) * 64;
    bf16x8 qf[4];
#pragma unroll
    for (int d0 = 0; d0 < 4; ++d0) qf[d0] = *(const bf16x8*)(Qp + 16 * d0 + 8 * hi);
    const bf16_t* KCp = (const bf16_t*)(ws + WS_KC) + (size_t)(b * 2 + g) * 128 * 64; const bf16_t* VCp = (const bf16_t*)(ws + WS_VC) + (size_t)(b * 2 + g) * 128 * 64;
    const size_t kvo = (size_t)(b * 2 + g) * 2048 * 64;
    const bf16_t* KSp = (const bf16_t*)(ws + WS_KS) + kvo; const bf16_t* VSp = (const bf16_t*)(ws + WS_VS) + kvo;
    const bf16_t* KWp = (const bf16_t*)(ws + WS_KW) + kvo; const bf16_t* VWp = (const bf16_t*)(ws + WS_VW) + kvo;
    LAS float* IMP = (LAS float*)(L + 4 * TILEB); LAS unsigned* SEL = (LAS unsigned*)(L + 4 * TILEB + 4 * 64 * 33 * 4);
    const int goff = (tid >> 3) * 64 + (tid & 7) * 8, loff = (tid >> 3) * TROW + (tid & 7) * 16;
    const float* ngp = (const float*)(ws + WS_NG) + tok * 24 + h;
    f32x16 res[2];
    u32x4 rk = *(const u32x4*)(KSp + (size_t)cur * 4096 + goff), rv = *(const u32x4*)(VSp + (size_t)cur * 4096 + goff);
    {
        const u32x4 rk0 = *(const u32x4*)(KCp + goff), rk1 = *(const u32x4*)(KCp + 4096 + goff), rv0 = *(const u32x4*)(VCp + goff), rv1 = *(const u32x4*)(VCp + 4096 + goff);
        __syncthreads();
        *(LAS u32x4*)(L + loff) = rk0; *(LAS u32x4*)(L + TILEB + loff) = rk1; *(LAS u32x4*)(L + 2 * TILEB + loff) = rv0; *(LAS u32x4*)(L + 3 * TILEB + loff) = rv1;
        __syncthreads();
        f32x16 p0, p1, p2, p3; qk_tile(p0, p1, L, qf, r32, hi); qk_tile(p2, p3, L + TILEB, qf, r32, hi);
        float mx = NEGF;
        const int thr = ((t - 31) >> 4) - 4 * hi;
#pragma unroll
        for (int r = 0; r < 16; ++r) {
            p0[r] = (kvc(0, r) <= thr) ? p0[r] : NEGF; p1[r] = (kvc(1, r) <= thr) ? p1[r] : NEGF; p2[r] = (kvc(2, r) <= thr) ? p2[r] : NEGF; p3[r] = (kvc(3, r) <= thr) ? p3[r] : NEGF;
            mx = fmaxf(fmaxf(mx, fmaxf(p0[r], p1[r])), fmaxf(p2[r], p3[r]));
        }
        mx = fmaxf(mx, __shfl_xor(mx, 32));
        float ls = 0.f;
#pragma unroll
        for (int r = 0; r < 16; ++r) {
            p0[r] = (p0[r] > -1e29f) ? __builtin_amdgcn_exp2f(p0[r] - mx) : 0.f; p1[r] = (p1[r] > -1e29f) ? __builtin_amdgcn_exp2f(p1[r] - mx) : 0.f;
            p2[r] = (p2[r] > -1e29f) ? __builtin_amdgcn_exp2f(p2[r] - mx) : 0.f; p3[r] = (p3[r] > -1e29f) ? __builtin_amdgcn_exp2f(p3[r] - mx) : 0.f;
            ls += (p0[r] + p1[r]) + (p2[r] + p3[r]);
        }
        ls += __shfl_xor(ls, 32);
        const float inv = ls > 0.f ? 1.0f / ls : 0.f;
#pragma unroll
        for (int r = 0; r < 16; ++r) { p0[r] *= inv; p1[r] *= inv; p2[r] *= inv; p3[r] *= inv; }
        float gs[16], tl[16], tlp[16];
#pragma unroll
        for (int c = 0; c < 4; ++c) {
            gs[c] = (p0[4 * c] + p0[4 * c + 1]) + (p0[4 * c + 2] + p0[4 * c + 3]); tl[c] = p0[4 * c + 3];
            gs[4 + c] = (p1[4 * c] + p1[4 * c + 1]) + (p1[4 * c + 2] + p1[4 * c + 3]); tl[4 + c] = p1[4 * c + 3];
            gs[8 + c] = (p2[4 * c] + p2[4 * c + 1]) + (p2[4 * c + 2] + p2[4 * c + 3]); tl[8 + c] = p2[4 * c + 3];
            gs[12 + c] = (p3[4 * c] + p3[4 * c + 1]) + (p3[4 * c + 2] + p3[4 * c + 3]); tl[12 + c] = p3[4 * c + 3];
        }
#pragma unroll
        for (int c = 0; c < 16; ++c) tlp[c] = __shfl_xor(tl[c], 32);
        LAS float* impr = IMP + (hh * 64 + ql) * 33;
        if (cur > 7)
#pragma unroll
        for (int c = 0; c < 16; ++c) {
            const float prev0 = (c > 0) ? tlp[c - 1] : 0.f;
            impr[2 * c + hi] = gs[c] + (hi ? tlp[c] : prev0);
        }
        f32x16 o[2]; o[0] = F16ZERO; o[1] = F16ZERO;
        pv_tile(o, L + 2 * TILEB, p0, p1, lane); pv_tile(o, L + 3 * TILEB, p2, p3, lane);
        const float g0 = ngp[0];
#pragma unroll
        for (int r = 0; r < 16; ++r) { res[0][r] = o[0][r] * g0; res[1][r] = o[1][r] * g0; }
        if (cur > 7) {
        __syncthreads();
        if (wid == 0) {
            float v[32];
#pragma unroll
            for (int j = 0; j < 32; ++j) v[j] = ((IMP[(0 * 64 + lane) * 33 + j] + IMP[(1 * 64 + lane) * 33 + j]) + IMP[(2 * 64 + lane) * 33 + j]) + IMP[(3 * 64 + lane) * 33 + j];
            unsigned mask;
            if (cur <= 7) mask = (2u << cur) - 1u;
            else {
                mask = 1u | (1u << (cur - 1)) | (1u << cur);
#pragma unroll
                for (int j = 1; j < 30; ++j) if (j > cur - 2) v[j] = -1.0f;
                for (int pick = 0; pick < 5; ++pick) {
                    float best = -0.5f; int bi = 1;
#pragma unroll
                    for (int j = 1; j < 30; ++j) { if (v[j] > best) { best = v[j]; bi = j; } }
                    mask |= 1u << bi;
#pragma unroll
                    for (int j = 1; j < 30; ++j) if (j == bi) v[j] = -1.0f;
                }
            }
            SEL[lane] = mask;
        }
        }
        __syncthreads();
    }
    const unsigned selm = (cur > 7) ? SEL[ql] : ((2u << cur) - 1u);
    const int n_slc = cur + 1, n_win = (cur + 1 < 5) ? cur + 1 : 5, total = n_slc + n_win;
    *(LAS u32x4*)(L + loff) = rk; *(LAS u32x4*)(L + 2 * TILEB + loff) = rv;
    __syncthreads();
    float mref = 0.f, lsum = 0.f; bool first = true; f32x16 o[2]; o[0] = F16ZERO; o[1] = F16ZERO;
    int cb = 0;
    for (int i = 0; i < total; ++i) {
        if (i + 1 < total) {
            const int i2 = i + 1; const bool w2 = i2 >= n_slc; const int j2 = w2 ? cur - (i2 - n_slc) : cur - i2;
            rk = *(const u32x4*)((w2 ? KWp : KSp) + (size_t)j2 * 4096 + goff); rv = *(const u32x4*)((w2 ? VWp : VSp) + (size_t)j2 * 4096 + goff);
        }
        const bool isw = i >= n_slc; const int j = isw ? cur - (i - n_slc) : cur - i;
        int mode = 0; bool sel = true;
        if (j == cur) mode = 1; else if (isw && j == cur - 4) mode = 2;
        if (!isw) sel = (selm >> j) & 1u;
        {
            const float cv = sel ? -mref : NEGF;
            f32x16 cc;
#pragma unroll
            for (int r = 0; r < 16; ++r) cc[r] = cv;
            f32x16 p0, p1; qk_tile_c(p0, p1, L + cb * TILEB, qf, r32, hi, cc);
            softmax_step_lazy(p0, p1, mref, lsum, o, 64 * j, t, mode, hi, first); first = false;
            pv_tile(o, L + (2 + cb) * TILEB, p0, p1, lane);
        }
        if (i == n_slc - 1 || i == total - 1) {
            const float lt = lsum + __shfl_xor(lsum, 32); const float gg = ngp[isw ? 16 : 8] / lt;
#pragma unroll
            for (int r = 0; r < 16; ++r) { res[0][r] += o[0][r] * gg; res[1][r] += o[1][r] * gg; }
            mref = 0.f; first = true; lsum = 0.f; o[0] = F16ZERO; o[1] = F16ZERO;
        }
        if (i + 1 < total) { *(LAS u32x4*)(L + (cb ^ 1) * TILEB + loff) = rk; *(LAS u32x4*)(L + (2 + (cb ^ 1)) * TILEB + loff) = rv; }
        __syncthreads();
        cb ^= 1;
    }
    const size_t tok0 = (size_t)b * 2048 + 64 * cur + 32 * qh;
    attn_rows_out(res, L + wid * (32 * OSTG), (const bf16_t*)(ws + WS_NZ) + tok0 * 512 + h * 64, (bf16_t*)(ws + WS_BACT) + tok0 * 512 + h * 64, lane);
}

#define XB_TMO      128
#define XB_XCNT(j)  (256  + 64 * (j))
#define XB_XSUB(j)  (1280 + 64 * (j))
#define XB_XGEN(j)  (2304 + 64 * (j))
#define XB_TOP      3328
#define XB_TOPGEN   3392
#define XCD_BAR_WORDS 3456
#define XB_SPIN_CAP (1u << 18)

__device__ __forceinline__ unsigned xb_ld(unsigned* p)              { return __hip_atomic_load(p, __ATOMIC_RELAXED, __HIP_MEMORY_SCOPE_AGENT); }
__device__ __forceinline__ unsigned xb_add(unsigned* p, unsigned v) { return __hip_atomic_fetch_add(p, v, __ATOMIC_RELAXED, __HIP_MEMORY_SCOPE_AGENT); }
__device__ __forceinline__ unsigned xb_xcc_id() { return (unsigned)__builtin_amdgcn_s_getreg((3 << 11) | 20) & 0xFu; }
#define XB_SPIN(cond, bar) do { unsigned _sp = 0; while (cond) { __builtin_amdgcn_s_sleep(1); \
    if ((++_sp & 255u) == 0u) { if (xb_ld(&(bar)[XB_TMO])) break; if (_sp > XB_SPIN_CAP) { atomicAdd(&(bar)[XB_TMO], 1u); break; } } } } while (0)

struct XcdBarrier {
    unsigned* bar; unsigned x;
    volatile LAS unsigned* st;
};

__device__ __forceinline__ XcdBarrier xcd_barrier_post(unsigned* bar, volatile LAS unsigned* st) {
    XcdBarrier b; b.bar = bar; b.x = xb_xcc_id(); b.st = st;
    if (threadIdx.x == 0) (void)xb_add(&bar[XB_XCNT(b.x)], 1u);
    return b;
}
__device__ __forceinline__ void xcd_barrier_complete(unsigned* bar, unsigned x, unsigned& nloc, unsigned& nx) {
    const unsigned G = gridDim.x * gridDim.y * gridDim.z;
    unsigned sum, cnt, mine, sp = 0u;
    for (;;) {
        sum = 0u; cnt = 0u; mine = 0u;
#pragma unroll
        for (unsigned j = 0; j < 16; ++j) { const unsigned c = xb_ld(&bar[XB_XCNT(j)]); sum += c; cnt += (c > 0u) ? 1u : 0u; mine = (j == x) ? c : mine; }
        if (sum == G) break;
        __builtin_amdgcn_s_sleep(1);
        if ((++sp & 255u) == 0u) { if (xb_ld(&bar[XB_TMO])) break; if (sp > XB_SPIN_CAP) { atomicAdd(&bar[XB_TMO], 1u); break; } }
    }
    nloc = mine > 0u ? mine : 1u; nx = cnt > 0u ? cnt : 1u;
}

__device__ __forceinline__ void xcd_barrier(const XcdBarrier& b) {
    asm volatile("s_waitcnt vmcnt(0)" ::: "memory");
    __syncthreads();
    if (threadIdx.x == 0) {
        unsigned* bar = b.bar;
        __builtin_amdgcn_s_waitcnt(0);
        unsigned nloc = b.st[0], nx = b.st[1];
        if (nloc == 0u) { xcd_barrier_complete(bar, b.x, nloc, nx); b.st[0] = nloc; b.st[1] = nx; }
        const unsigned old = xb_add(&bar[XB_XSUB(b.x)], 1u);
        const unsigned gen = old / nloc;
        if (old + 1u == (gen + 1u) * nloc) {
            __builtin_amdgcn_fence(__ATOMIC_RELEASE, "agent");
            asm volatile("s_waitcnt vmcnt(0)" ::: "memory");
            const unsigned og = xb_add(&bar[XB_TOP], 1u);
            const unsigned tg = og / nx;
            if (og + 1u == (tg + 1u) * nx) xb_add(&bar[XB_TOPGEN], 1u);
            else XB_SPIN(xb_ld(&bar[XB_TOPGEN]) == tg, bar);
            __builtin_amdgcn_fence(__ATOMIC_ACQUIRE, "agent");
            xb_add(&bar[XB_XGEN(b.x)], 1u);
            asm volatile("s_waitcnt vmcnt(0)" ::: "memory");
        } else {
            XB_SPIN(xb_ld(&bar[XB_XGEN(b.x)]) == gen, bar);
            __builtin_amdgcn_fence(__ATOMIC_ACQUIRE, "agent");
            asm volatile("s_waitcnt vmcnt(0)" ::: "memory");
        }
    }
    __syncthreads();
}

__global__ void __launch_bounds__(512, 2) mega_fwd(Args a) {
    extern __shared__ __attribute__((aligned(16))) unsigned char lds_raw[];
    LAS unsigned char* L = (LAS unsigned char*)lds_raw;
    cg::grid_group grid = cg::this_grid();
    int ph = a.ph_lo;
    const int wid0 = __builtin_amdgcn_readfirstlane(threadIdx.x >> 6);
    volatile LAS unsigned* bst = (volatile LAS unsigned*)(L + 131072 + 64);
    if (threadIdx.x < 16) bst[threadIdx.x] = 0u;
    __syncthreads();
    const XcdBarrier xbar = xcd_barrier_post((unsigned*)(a.ws + WS_BAR), bst);
#define SEAM() do { if (a.use_cg) grid.sync(); else xcd_barrier(xbar); } while (0)
    if (ph == 0) {
        const int tid = threadIdx.x, lane = tid & 63, wid = __builtin_amdgcn_readfirstlane(tid >> 6);
        phase0(a, a.ws, L, tid, lane, wid);
        if (gridDim.x == 256) {
            if (tid == 0) {
                unsigned* cA = (unsigned*)(a.ws + WS_BAR) + 3456; unsigned* cB = (unsigned*)(a.ws + WS_BAR) + 3520; unsigned sp = 0;
                while (__hip_atomic_load(cA, __ATOMIC_RELAXED, __HIP_MEMORY_SCOPE_AGENT) < 48u || __hip_atomic_load(cB, __ATOMIC_RELAXED, __HIP_MEMORY_SCOPE_AGENT) < 128u) { __builtin_amdgcn_s_sleep(2); if (++sp > (1u << 22)) break; }
            }
            __syncthreads();
            if (blockIdx.x == 255) {
                for (int e = tid; e < 1024; e += 512) { float* pp = (float*)(a.ws + WS_B1P) + (size_t)(e >> 7) * 16 * 128 + (e & 127); float sacc = 0.f;
#pragma unroll
                    for (int q = 0; q < 16; ++q) sacc += __hip_atomic_load(pp + q * 128, __ATOMIC_RELAXED, __HIP_MEMORY_SCOPE_AGENT);
                    ((float*)(a.ws + WS_B1))[e] = sacc; }
            }
            phase1(a, a.ws, a.in[0], 0, lane, (int)blockIdx.x * 8 + wid, 2048, MTOK);
        }
        ++ph;
        if (ph < a.ph_hi) SEAM();
    }
    int rep_done = 0;
    for (; ph < a.ph_hi; ) {
        __attribute__((address_space(1))) unsigned char* ws_g = (__attribute__((address_space(1))) unsigned char*)a.ws; asm volatile("" : "+s"(ws_g));
        unsigned char* ws = (unsigned char*)ws_g;
        int lane_l = __builtin_amdgcn_mbcnt_hi(~0u, __builtin_amdgcn_mbcnt_lo(~0u, 0u)), wid_l = wid0; asm volatile("" : "+v"(lane_l), "+s"(wid_l));
        const int lane = lane_l, wid = wid_l, tid = wid * 64 + lane;
        int bid = blockIdx.x, gdim = gridDim.x; asm volatile("" : "+s"(bid), "+s"(gdim));
        if ((ph - 1) % 5 == 0 && gdim == 256) { ++ph; continue; }
        {
            const int l = (ph - 1) / 5, k = (ph - 1) % 5;
            const float* xin = (l == 0) ? a.in[0] : a.out;
            if (k == 0) {
                if (l == 0 && bid == gdim - 1) {
                    for (int e = tid; e < 1024; e += 512) { const float* pp = (const float*)(ws + WS_B1P) + (size_t)(e >> 7) * 16 * 128 + (e & 127); float sacc = 0.f;
#pragma unroll
                        for (int q = 0; q < 16; ++q) sacc += pp[q * 128];
                        ((float*)(ws + WS_B1))[e] = sacc; }
                }
                phase1(a, ws, xin, l, lane, bid * 8 + wid, gdim * 8, MTOK);
            }
            else if (k == 1) {
                pg8::Gemm gm{(const pg8::bf16_t*)(ws + WS_H), (const pg8::bf16_t*)(ws + WS_WINT) + (size_t)l * NINP * 1024, MTOK, NINP, 1024};
                pg8::StaticOrder S; S.init(MTOK, NINP, gdim, bid);
                EpiIn E{ws, a.in[6] + l * 64, a.in[8] + l * 64, a.in[9] + l * 64};
                pg8::gemm_phase<EpiIn, pg8::StaticOrder, true, true>((PG8_LAS unsigned char*)L, gm, S, E, tid);
            } else if (k == 2) {
                for (int u = bid; u < 256; u += gdim) {
                    cmp_unit(a, ws, L, l, u, tid, lane, wid);
                    asm volatile("s_waitcnt vmcnt(0)" ::: "memory");
                    __syncthreads();
                    if (tid == 0) { __builtin_amdgcn_fence(__ATOMIC_RELEASE, "agent"); asm volatile("s_waitcnt vmcnt(0)" ::: "memory");
                        __hip_atomic_fetch_add((unsigned*)(ws + WS_BAR) + 3584 + 64 * l, 1u, __ATOMIC_RELAXED, __HIP_MEMORY_SCOPE_AGENT); }
                }
                __syncthreads();
                for (int c = bid; c < 256; c += gdim)
                    for (int i = 0; i < 2; ++i) { const int bh = (c >> 3) + 32 * i, qt = 8 * (c & 7) + wid; sb_wave_unit(ws, L + wid * TILEB, bh >> 3, bh & 7, qt, lane); }
                if (tid == 0) {
                    unsigned* cnt = (unsigned*)(ws + WS_BAR) + 3584 + 64 * l; unsigned sp = 0;
                    while (__hip_atomic_load(cnt, __ATOMIC_RELAXED, __HIP_MEMORY_SCOPE_AGENT) < 256u) { __builtin_amdgcn_s_sleep(2); if (++sp > (1u << 22)) break; }
                    __builtin_amdgcn_fence(__ATOMIC_ACQUIRE, "agent");
                    asm volatile("s_waitcnt vmcnt(0)" ::: "memory");
                }
                __syncthreads();
                for (int c = bid; c < 256; c += gdim) {
                    const int bg = c & 15, s = c >> 4;
                    nsa_unit(ws, L, bg >> 1, bg & 1, 31 - s, tid, lane, wid);
                    nsa_unit(ws, L, bg >> 1, bg & 1, s, tid, lane, wid);
                }
            } else if (k == 3) {
                OrderAB S; S.base.init(MTOK, 1024, gdim, bid);
                pg8::Gemm gm{(const pg8::bf16_t*)(ws + WS_AACT), (const pg8::bf16_t*)(ws + WS_WABT) + (size_t)l * 2048 * 512, 2 * MTOK, 2048, 512};
                EpiAB E{ws}; pg8::gemm_phase<EpiAB, OrderAB, true, true>((PG8_LAS unsigned char*)L, gm, S, E, tid);
            } else {
                pg8::StaticOrder S; S.init(MTOK, 1024, gdim, bid);
                pg8::Gemm gm{(const pg8::bf16_t*)(ws + WS_Y), (const pg8::bf16_t*)(ws + WS_WOT) + (size_t)l * 1024 * 1024, MTOK, 1024, 1024};
                const int ln = (l < 3) ? l + 1 : l;
                EpiOutNorm E{ws, xin, a.out, (const float*)(ws + WS_MOD) + (size_t)l * 8 * 3072 + 2048, a.in[4] + ln * 1024, (const float*)(ws + WS_MOD) + (size_t)ln * 8 * 3072,
                             (unsigned*)(ws + WS_BAR) + 3840 + 64 * l, (l < 3 && gdim == 256) ? 1 : 0};
                pg8::gemm_phase<EpiOutNorm, pg8::StaticOrder, false, true>((PG8_LAS unsigned char*)L, gm, S, E, tid);
            }
        }
        if (PROBE_N > 1 && (ph - 1) % 5 == PROBE_K && rep_done + 1 < PROBE_N) { ++rep_done; SEAM(); continue; }
        rep_done = 0;
        if (ph + 1 < a.ph_hi) { SEAM(); if (PROBE_K == 99 && PROBE_N > 1) SEAM(); }
        ++ph;
    }
}

#ifndef MK_PER_PHASE
#define MK_PER_PHASE 0
#endif
extern "C" void kernel_launch(void* const* d_in, const int* in_sizes, int n_in, void* d_out, int out_size, void* d_ws, size_t ws_size, hipStream_t stream) {
    static int grid = 0;
    if (grid == 0) {
        if (n_in != 19 || out_size != MTOK * DM || ws_size < WS_END) { fprintf(stderr, "kernel_launch: unexpected shapes (n_in %d out %d ws %zu need %zu)\n", n_in, out_size, ws_size, (size_t)WS_END); grid = -1; return; }
        int dev = 0, cus = 0, per_cu = 0;
        hipGetDevice(&dev); hipDeviceGetAttribute(&cus, hipDeviceAttributeMultiprocessorCount, dev);
        if (hipFuncSetAttribute((const void*)mega_fwd, hipFuncAttributeMaxDynamicSharedMemorySize, LDS_BYTES) != hipSuccess) { fprintf(stderr, "kernel_launch: hipFuncSetAttribute failed\n"); grid = -1; return; }
        if (hipOccupancyMaxActiveBlocksPerMultiprocessor(&per_cu, (const void*)mega_fwd, 512, LDS_BYTES) != hipSuccess || per_cu < 1) { fprintf(stderr, "kernel_launch: occupancy query says %d\n", per_cu); per_cu = 1; }
        (void)hipGetLastError();
        grid = cus * 1;
        if (grid > 256) grid = 256;
    }
    if (grid < 0) return;
    Args a{};
    for (int i = 0; i < 19; ++i) a.in[i] = (const float*)d_in[i];
    a.out = (float*)d_out; a.ws = (unsigned char*)d_ws; a.use_cg = 0; a.pad = 0;
    if (hipMemsetAsync((unsigned char*)d_ws + WS_BAR, 0, 16384, stream) != hipSuccess) { fprintf(stderr, "kernel_launch: memset failed\n"); return; }
#if MK_PER_PHASE
    for (int ph = 0; ph < 21; ++ph) { a.ph_lo = ph; a.ph_hi = ph + 1; hipLaunchKernelGGL(mega_fwd, dim3(grid), dim3(512), LDS_BYTES, stream, a); }
#else
    a.ph_lo = 0; a.ph_hi = 21;
    void* args[] = {&a};
    hipError_t e = hipLaunchCooperativeKernel((const void*)mega_fwd, dim3(grid), dim3(512), args, LDS_BYTES, stream);
    if (e != hipSuccess) fprintf(stderr, "cooperative launch failed: %s (grid %d)\n", hipGetErrorString(e), grid);
#endif
}
```

```cpp
#include <hip/hip_runtime.h>
#include <hip/hip_cooperative_groups.h>
#include <cstdio>
#include <cstdint>
namespace cg = cooperative_groups;
namespace pg8 {
#define PG8_LAS __attribute__((address_space(3)))
typedef unsigned short bf16_t;
typedef short bf16x8 __attribute__((ext_vector_type(8)));
typedef float f32x4 __attribute__((ext_vector_type(4)));
typedef unsigned u32x4 __attribute__((ext_vector_type(4)));
constexpr int BM = 256, BK = 64, HALF = 128, HTB = HALF * BK * 2  , STAGE_BYTES = 8 * HTB, NXCD = 8, WGM = 8;

__host__ __device__ __forceinline__ int lds_byte(int r, int c) { const int st = (r >> 4) * 2 + (c >> 5), rr = r & 15, cc = c & 31, ob = rr * 64 + cc * 2; return st * 1024 + (ob ^ (((ob >> 9) & 1) << 5)); }
__host__ __device__ __forceinline__ void stage_rc(int b, int& R, int& C) { const int st = b / 1024, sb = b % 1024, swz = sb ^ (((sb >> 9) & 1) << 5); R = (st >> 1) * 16 + swz / 64; C = (st & 1) * 32 + (swz % 64) / 2; }
__host__ __device__ __forceinline__ int perm32(int rho) { const int n = rho >> 4, i = rho & 15; return 8 * (i >> 2) + 4 * n + (i & 3); }

struct Unit { int pm, pn; };
struct Gemm { const bf16_t* A; const bf16_t* Bt; int M, N, K; };

struct StaticOrder {
    int nM, nN, nwg, G, c;
    __host__ __device__ void init(int M, int N, int G_, int c_) { nM = M / BM; nN = N / BM; nwg = nM * nN; G = G_; c = c_; }
    __host__ __device__ bool next(int i, Unit& u) const {
        const long L = (long)i * G + c; if (L >= nwg) return false;
        int wgid = (int)L; { const int q = nwg / NXCD, r = nwg % NXCD, xcd = wgid % NXCD, off = wgid / NXCD; wgid = (xcd < r ? xcd * (q + 1) : r * (q + 1) + (xcd - r) * q) + off; }
        const int nig = WGM * nN, gid = wgid / nig, fm = gid * WGM, gsz = (nM - fm) < WGM ? (nM - fm) : WGM;
        u.pm = fm + ((wgid % nig) % gsz); u.pn = (wgid % nig) / gsz; return true;
    }
    __device__ __forceinline__ void a_ready(const Unit&) const {}
    __device__ __forceinline__ void done(const Unit&) const {}
};

__device__ __forceinline__ unsigned cvt_pk_bf16(float lo, float hi) { unsigned r; asm volatile("v_cvt_pk_bf16_f32 %0, %1, %2" : "=v"(r) : "v"(lo), "v"(hi)); return r; }
typedef float f32x2 __attribute__((ext_vector_type(2)));
__device__ __forceinline__ f32x2 gelu_pk(f32x2 v) {
    const f32x2 av = __builtin_elementwise_abs(v), d = av * 0.2316418882f + 1.0f;
    f32x2 t; t.x = __builtin_amdgcn_rcpf(d.x); t.y = __builtin_amdgcn_rcpf(d.y);
    f32x2 q = t * 0.5307027145f + (-0.7265760135f); q = q * t + 0.7107068705f; q = q * t + (-0.142248368f); q = q * t + 0.127414796f; q = q * t;
    const f32x2 s = (v * v) * (-0.72134752044f);
    f32x2 e; e.x = __builtin_amdgcn_exp2f(s.x); e.y = __builtin_amdgcn_exp2f(s.y);
    const f32x2 m = v * (q * e), r = v - m;
    f32x2 o; o.x = v.x < 0.f ? m.x : r.x; o.y = v.y < 0.f ? m.y : r.y; return o;
}

template <int ACT  > struct EpiBf16 {
    static constexpr bool PERM = true, AFTER_DRAIN = false; static_assert(ACT == 0 || ACT == 1, "EpiBf16: ACT is 0 (none) or 1 (gelu_pk)");
    bf16_t* O; int ldc; const float* bias; int split_cols; size_t split_stride; float scale0;
    __device__ __forceinline__ void operator()(const f32x4 (&acc)[2][2][4][2], const Unit& u, int wr, int wc, int fr, int fq) const {
        const int row0 = u.pm * BM + wr * 64 + fr; int colt = u.pn * BM; bf16_t* base = O;
        float sc = 1.f; if (split_cols) { const int t = colt / split_cols; base += (size_t)t * split_stride; colt -= t * split_cols; if (t == 0) sc = scale0; }
        const int col0 = colt + wc * 32 + 8 * fq, bcol0 = u.pn * BM + wc * 32 + 8 * fq;
        f32x4 bv[2][2];
#pragma unroll
        for (int bj = 0; bj < 2; ++bj)
#pragma unroll
            for (int n = 0; n < 2; ++n) bv[bj][n] = bias ? *(const f32x4*)(bias + bcol0 + bj * HALF + 4 * n) : (f32x4){0.f, 0.f, 0.f, 0.f};
#pragma unroll
        for (int ai = 0; ai < 2; ++ai)
#pragma unroll
            for (int m = 0; m < 4; ++m) { bf16_t* rowp = base + (size_t)(row0 + ai * HALF + m * 16) * ldc + col0;
#pragma unroll
                for (int bj = 0; bj < 2; ++bj) { f32x4 v0 = acc[ai][bj][m][0] + bv[bj][0], v1 = acc[ai][bj][m][1] + bv[bj][1];
                    if (ACT == 1) { f32x2 a = gelu_pk((f32x2){v0[0], v0[1]}), b = gelu_pk((f32x2){v0[2], v0[3]}), c = gelu_pk((f32x2){v1[0], v1[1]}), d = gelu_pk((f32x2){v1[2], v1[3]});
                        v0 = (f32x4){a.x, a.y, b.x, b.y}; v1 = (f32x4){c.x, c.y, d.x, d.y}; }
                    v0 = v0 * sc; v1 = v1 * sc; u32x4 w; w.x = cvt_pk_bf16(v0[0], v0[1]); w.y = cvt_pk_bf16(v0[2], v0[3]); w.z = cvt_pk_bf16(v1[0], v1[1]); w.w = cvt_pk_bf16(v1[2], v1[3]);
                    *(u32x4*)(rowp + bj * HALF) = w; } }
    }
};

struct PanelStats {
    unsigned* xbuf;
    unsigned* cnt;
    unsigned* tmo;
    int ntn; float eps;
    unsigned code;
    __device__ __forceinline__ bool run(const f32x4 (&v)[2][2][4][2], const Unit& u, int wr, int wc, int fr, int fq, PG8_LAS unsigned char* lds, int wid, int lane) const {
        typedef float f32x2v __attribute__((ext_vector_type(2)));
        PG8_LAS f32x2v* P = (PG8_LAS f32x2v*)lds;
        PG8_LAS f32x2v* S = (PG8_LAS f32x2v*)(lds + 8192);
        PG8_LAS unsigned* flag = (PG8_LAS unsigned*)(lds + 8192 + 2048);
#pragma unroll
        for (int ai = 0; ai < 2; ++ai)
#pragma unroll
            for (int m = 0; m < 4; ++m) {
                float s = 0.f;
#pragma unroll
                for (int bj = 0; bj < 2; ++bj)
#pragma unroll
                    for (int n = 0; n < 2; ++n) { const f32x4 x = v[ai][bj][m][n]; s += (x[0] + x[1]) + (x[2] + x[3]); }
                s += __shfl_xor(s, 16); s += __shfl_xor(s, 32);
                const float mw = s * (1.0f / 64.0f); float q = 0.f;
#pragma unroll
                for (int bj = 0; bj < 2; ++bj)
#pragma unroll
                    for (int n = 0; n < 2; ++n) { const f32x4 d = v[ai][bj][m][n] - mw; q += (d[0] * d[0] + d[1] * d[1]) + (d[2] * d[2] + d[3] * d[3]); }
                q += __shfl_xor(q, 16); q += __shfl_xor(q, 32);
                if (fq == 0) P[(ai * HALF + wr * 64 + m * 16 + fr) * 4 + wc] = (f32x2v){mw, q};
            }
        asm volatile("s_waitcnt lgkmcnt(0)" ::: "memory"); __builtin_amdgcn_s_barrier(); asm volatile("" ::: "memory");
#if defined(BROKEN_EXCHANGE_NO_WAIT)
#warning BROKEN CONTROL BUILD: the row-statistics exchange does not wait; results are wrong by design
        if (blockIdx.x >= 64) { const long long t0_ = clock64(); while (clock64() - t0_ < 60000) __builtin_amdgcn_s_sleep(8); }
#endif
        const int row = wid * 32 + (lane & 31);
        if (lane < 32) {
            const f32x2v a = P[row * 4 + 0], b = P[row * 4 + 1], c = P[row * 4 + 2], d = P[row * 4 + 3];
            const float mt = (a.x + b.x + c.x + d.x) * 0.25f;
            const float da = a.x - mt, db = b.x - mt, dc = c.x - mt, dd = d.x - mt;
            const float m2 = (a.y + b.y) + (c.y + d.y) + 64.0f * ((da * da + db * db) + (dc * dc + dd * dd));
            unsigned long long* slot = (unsigned long long*)xbuf + ((size_t)(u.pm * BM + row) * 4 + u.pn);
            __hip_atomic_store(slot, ((unsigned long long)__float_as_uint(m2) << 32) | __float_as_uint(mt), __ATOMIC_RELAXED, __HIP_MEMORY_SCOPE_AGENT);
        }
        asm volatile("s_waitcnt vmcnt(0)" ::: "memory");
        if (lane == 0) __hip_atomic_fetch_add(cnt + 64 * u.pm, 1u, __ATOMIC_RELAXED, __HIP_MEMORY_SCOPE_AGENT);
        if (wid == 0) {
            bool dead = false; const unsigned long long t0 = __builtin_amdgcn_s_memrealtime(); const unsigned want = 8u * (unsigned)ntn;
            for (;;) {
#if defined(BROKEN_EXCHANGE_NO_WAIT)
                break;
#endif
                if ((unsigned)__builtin_amdgcn_readfirstlane(__hip_atomic_load(cnt + 64 * u.pm, __ATOMIC_RELAXED, __HIP_MEMORY_SCOPE_AGENT)) >= want) break;
                if (__builtin_amdgcn_s_memrealtime() - t0 > 2000000ull) {
                    if (lane == 0) { unsigned expect = 0u; __hip_atomic_compare_exchange_strong(tmo + 1, &expect, code | (unsigned)(u.pm & 0xff), __ATOMIC_RELAXED, __ATOMIC_RELAXED, __HIP_MEMORY_SCOPE_AGENT);
                                     __hip_atomic_store(tmo, 1u, __ATOMIC_RELAXED, __HIP_MEMORY_SCOPE_AGENT); }
                    dead = true; break; }
                __builtin_amdgcn_s_sleep(2);
            }
            __builtin_amdgcn_fence(__ATOMIC_ACQUIRE, "agent");
            if (lane == 0) flag[0] = dead ? 1u : 0u;
        }
        asm volatile("s_waitcnt vmcnt(0) lgkmcnt(0)" ::: "memory"); __builtin_amdgcn_s_barrier(); asm volatile("" ::: "memory");
        const bool bad = flag[0] != 0u;
        if (lane < 32) {
            const unsigned long long* slot = (const unsigned long long*)xbuf + (size_t)(u.pm * BM + row) * 4; float mt[4], m2[4]; float ms = 0.f;
#pragma unroll
            for (int t = 0; t < 4; ++t) { if (t < ntn) { const unsigned long long w = __hip_atomic_load(slot + t, __ATOMIC_RELAXED, __HIP_MEMORY_SCOPE_AGENT); mt[t] = __uint_as_float((unsigned)w); m2[t] = __uint_as_float((unsigned)(w >> 32)); } else { mt[t] = 0.f; m2[t] = 0.f; } ms += mt[t]; }
            const float mean = ms / (float)ntn; float q = 0.f;
#pragma unroll
            for (int t = 0; t < 4; ++t) if (t < ntn) { const float dm = mt[t] - mean; q += m2[t] + 256.0f * dm * dm; }
            S[row] = (f32x2v){mean, 1.0f / sqrtf(q / (256.0f * (float)ntn) + eps)};
        }
        asm volatile("s_waitcnt lgkmcnt(0)" ::: "memory"); __builtin_amdgcn_s_barrier(); asm volatile("" ::: "memory");
        return bad;
    }
};
struct EpiLnRes {
    static constexpr bool PERM = false, AFTER_DRAIN = true;
    const float* base; float* out; int ldc; const float* bias; PanelStats st; unsigned poison;
    __device__ __forceinline__ void fused(f32x4 (&acc)[2][2][4][2], const Unit& u, int wr, int wc, int fr, int fq, PG8_LAS unsigned char* lds, int wid, int lane) const {
        typedef float f32x2v __attribute__((ext_vector_type(2)));
        const PG8_LAS f32x2v* S = (const PG8_LAS f32x2v*)(lds + 8192);
        const int col0 = u.pn * BM + wc * 32 + 4 * fq;
#pragma unroll
        for (int bj = 0; bj < 2; ++bj)
#pragma unroll
            for (int n = 0; n < 2; ++n) { const f32x4 bv = bias ? *(const f32x4*)(bias + col0 + bj * HALF + n * 16) : (f32x4){0.f, 0.f, 0.f, 0.f};
#pragma unroll
                for (int ai = 0; ai < 2; ++ai)
#pragma unroll
                    for (int m = 0; m < 4; ++m) acc[ai][bj][m][n] += bv; }
        f32x4 pre[4][2][2];
#pragma unroll
        for (int m = 0; m < 4; ++m) { const size_t off = (size_t)(u.pm * BM + wr * 64 + m * 16 + fr) * ldc + col0;
#pragma unroll
            for (int bj = 0; bj < 2; ++bj)
#pragma unroll
                for (int n = 0; n < 2; ++n) pre[m][bj][n] = *(const f32x4*)(base + off + bj * HALF + n * 16); }
        const bool bad = st.run(acc, u, wr, wc, fr, fq, lds, wid, lane) || poison != 0u;
        const float qnan = __builtin_nanf("");
#pragma unroll
        for (int ai = 0; ai < 2; ++ai)
#pragma unroll
            for (int m = 0; m < 4; ++m) { const int r = ai * HALF + wr * 64 + m * 16 + fr; const f32x2v sr = S[r]; const size_t off = (size_t)(u.pm * BM + r) * ldc + col0;
#pragma unroll
                for (int bj = 0; bj < 2; ++bj)
#pragma unroll
                    for (int n = 0; n < 2; ++n) { const f32x4 bs = ai == 0 ? pre[m][bj][n] : *(const f32x4*)(base + off + bj * HALF + n * 16); f32x4 o = bs + (acc[ai][bj][m][n] - sr.x) * sr.y;
                        if (bad) o = (f32x4){qnan, qnan, qnan, qnan}; *(f32x4*)(out + off + bj * HALF + n * 16) = o; }
                if (m & 1) asm volatile("" ::: "memory"); }
    }
};
struct EpiLnResLn {
    static constexpr bool PERM = false, AFTER_DRAIN = true;
    const float* base; float* out; bf16_t* xn; int ldc; const float* bias; PanelStats st1, st2; unsigned poison;
    __device__ __forceinline__ void fused(f32x4 (&acc)[2][2][4][2], const Unit& u, int wr, int wc, int fr, int fq, PG8_LAS unsigned char* lds, int wid, int lane) const {
        typedef float f32x2v __attribute__((ext_vector_type(2))); typedef unsigned u32x2v __attribute__((ext_vector_type(2)));
        const PG8_LAS f32x2v* S = (const PG8_LAS f32x2v*)(lds + 8192);
        const int col0 = u.pn * BM + wc * 32 + 4 * fq;
#pragma unroll
        for (int bj = 0; bj < 2; ++bj)
#pragma unroll
            for (int n = 0; n < 2; ++n) { const f32x4 bv = bias ? *(const f32x4*)(bias + col0 + bj * HALF + n * 16) : (f32x4){0.f, 0.f, 0.f, 0.f};
#pragma unroll
                for (int ai = 0; ai < 2; ++ai)
#pragma unroll
                    for (int m = 0; m < 4; ++m) acc[ai][bj][m][n] += bv; }
        bool bad = st1.run(acc, u, wr, wc, fr, fq, lds, wid, lane) || poison != 0u;
        const float qnan = __builtin_nanf("");
#pragma unroll
        for (int ai = 0; ai < 2; ++ai)
#pragma unroll
            for (int m = 0; m < 4; ++m) { const int r = ai * HALF + wr * 64 + m * 16 + fr; const f32x2v sr = S[r]; const size_t off = (size_t)(u.pm * BM + r) * ldc + col0;
#pragma unroll
                for (int bj = 0; bj < 2; ++bj)
#pragma unroll
                    for (int n = 0; n < 2; ++n) { const f32x4 bs = *(const f32x4*)(base + off + bj * HALF + n * 16); acc[ai][bj][m][n] = bs + (acc[ai][bj][m][n] - sr.x) * sr.y; }
                asm volatile("" : "+v"(acc[ai][0][m][0]), "+v"(acc[ai][0][m][1]), "+v"(acc[ai][1][m][0]), "+v"(acc[ai][1][m][1]));
                if (m & 1) asm volatile("" ::: "memory"); }
        const bool bad1 = bad;
        bad = st2.run(acc, u, wr, wc, fr, fq, lds, wid, lane) || bad;
#pragma unroll
        for (int ai = 0; ai < 2; ++ai)
#pragma unroll
            for (int m = 0; m < 4; ++m) { const int r = ai * HALF + wr * 64 + m * 16 + fr; const f32x2v sr = S[r]; const size_t off = (size_t)(u.pm * BM + r) * ldc + col0;
#pragma unroll
                for (int bj = 0; bj < 2; ++bj)
#pragma unroll
                    for (int n = 0; n < 2; ++n) { const f32x4 x1 = acc[ai][bj][m][n]; *(f32x4*)(out + off + bj * HALF + n * 16) = bad1 ? (f32x4){qnan, qnan, qnan, qnan} : x1;
                        const f32x4 o = (x1 - sr.x) * sr.y; u32x2v w; w.x = cvt_pk_bf16(o[0], o[1]); w.y = cvt_pk_bf16(o[2], o[3]);
                        if (bad) { w.x = 0x7fc07fc0u; w.y = 0x7fc07fc0u; } *(u32x2v*)(xn + off + bj * HALF + n * 16) = w; }
                asm volatile("" ::: "memory"); }
    }
};

template <class Epi, class Sched, bool ALIGN_EPI = false, bool SP2 = false>
__device__ __forceinline__ void gemm_phase(PG8_LAS unsigned char* lds, const Gemm g, const Sched& S, const Epi& E, int tid_in) {
    int tid_l = tid_in; asm volatile("" : "+v"(tid_l));
    const int tid = tid_l, wid = __builtin_amdgcn_readfirstlane(tid >> 6), lane = tid & 63, wr = wid >> 2, wc = wid & 3, fr = lane & 15, fq = lane >> 4;
    const int K = g.K, nt = K / BK;
    unsigned voffA[2], voffB[2];
#pragma unroll
    for (int i = 0; i < 2; ++i) { int R, C; stage_rc(tid * 16 + i * 8192, R, C); const int Rb = Epi::PERM ? ((R & ~31) + perm32(R & 31)) : R;
        voffA[i] = (unsigned)(R * K + C) * 2u; voffB[i] = (unsigned)(Rb * K + C) * 2u; }
    const size_t kstep = (size_t)(BK * 2);
    const size_t hstep = (size_t)HALF * K * 2;
    const size_t tstep = 2 * hstep;
    const unsigned ldsw = (unsigned)wid * 1024u;
    const int aoff = lds_byte(wr * 64 + fr, fq * 8), boff = lds_byte(wc * 32 + fr, fq * 8);
#define PG8_SA(b, h) (((b) * 2 + (h)) * HTB)
#define PG8_SB(b, h) ((4 + (b) * 2 + (h)) * HTB)
#define PG8_STAGE(bufoff, gbase, voff) do { _Pragma("unroll") for (int _i = 0; _i < 2; ++_i) \
        __builtin_amdgcn_global_load_lds((const unsigned*)((const char*)(gbase) + (voff)[_i]), (PG8_LAS unsigned*)(lds + (bufoff) + ldsw + _i * 8192), 16, 0, 0); } while (0)
#define PG8_LDA(dst, b, h) do { _Pragma("unroll") for (int m = 0; m < 4; ++m) _Pragma("unroll") for (int k = 0; k < 2; ++k) dst[m][k] = *(const PG8_LAS bf16x8*)(lds + PG8_SA(b, h) + aoff + m * 2048 + k * 1024); } while (0)
#define PG8_LDB(dst, b, h) do { _Pragma("unroll") for (int n = 0; n < 2; ++n) _Pragma("unroll") for (int k = 0; k < 2; ++k) dst[n][k] = *(const PG8_LAS bf16x8*)(lds + PG8_SB(b, h) + boff + n * 2048 + k * 1024); } while (0)
#define PG8_MMA(ai, bj, At, Bt) do { __builtin_amdgcn_s_setprio(1); _Pragma("unroll") for (int m = 0; m < 4; ++m) _Pragma("unroll") for (int n = 0; n < 2; ++n) _Pragma("unroll") for (int k = 0; k < 2; ++k) \
        acc[ai][bj][m][n] = __builtin_amdgcn_mfma_f32_16x16x32_bf16(Bt[n][k], At[m][k], acc[ai][bj][m][n], 0, 0, 0); __builtin_amdgcn_s_setprio(0); } while (0)
#define PG8_WAIT_V(n) asm volatile("s_waitcnt vmcnt(" #n ")" ::: "memory")
#define PG8_WAIT_L(n) asm volatile("s_waitcnt lgkmcnt(" #n ")" ::: "memory")
#define PG8_BAR __builtin_amdgcn_s_barrier()
#define PG8_SCHED __builtin_amdgcn_sched_barrier(0)
    Unit cur, nxt; int ui = 0;
    if (!S.next(0, cur)) return;
    f32x4 acc[2][2][4][2];
#pragma unroll
    for (int a = 0; a < 2; ++a)
#pragma unroll
        for (int b = 0; b < 2; ++b)
#pragma unroll
            for (int m = 0; m < 4; ++m)
#pragma unroll
                for (int n = 0; n < 2; ++n) acc[a][b][m][n] = (f32x4){0.f, 0.f, 0.f, 0.f};
    bf16x8 At[4][2], B0[2][2], B1[2][2];
    const char* cA = (const char*)g.A + (size_t)cur.pm * tstep; const char* cB = (const char*)g.Bt + (size_t)cur.pn * tstep;
    S.a_ready(cur);
    if constexpr (Epi::INIT) E.init_load(acc, cur, wr, wc, fr, fq);
    if constexpr (SP2) {
        PG8_STAGE(PG8_SB(0, 0), cB, voffB); PG8_STAGE(PG8_SB(0, 1), cB + hstep, voffB); PG8_STAGE(PG8_SA(0, 0), cA, voffA); PG8_STAGE(PG8_SA(0, 1), cA + hstep, voffA);
        if (wr == 1) PG8_BAR;
        PG8_WAIT_V(2); PG8_BAR;
        PG8_STAGE(PG8_SB(1, 0), cB + kstep, voffB); PG8_STAGE(PG8_SA(1, 0), cA + kstep, voffA); PG8_STAGE(PG8_SB(1, 1), cB + hstep + kstep, voffB);
        PG8_WAIT_V(6); PG8_BAR;
    } else {
        PG8_STAGE(PG8_SB(0, 0), cB, voffB); PG8_STAGE(PG8_SA(0, 0), cA, voffA); PG8_STAGE(PG8_SB(0, 1), cB + hstep, voffB); PG8_STAGE(PG8_SA(0, 1), cA + hstep, voffA);
        if (wr == 1) PG8_BAR;
        PG8_WAIT_V(4); PG8_BAR;
        PG8_STAGE(PG8_SB(1, 0), cB + kstep, voffB); PG8_STAGE(PG8_SA(1, 0), cA + kstep, voffA); PG8_STAGE(PG8_SB(1, 1), cB + hstep + kstep, voffB);
        PG8_WAIT_V(6); PG8_BAR;
    }
    if constexpr (Epi::INIT) E.init_scale(acc, cur, wr, wc, fr, fq);
    for (;;) {
        const bool has_next = S.next(ui + 1, nxt);
        const char* nA = has_next ? (const char*)g.A + (size_t)nxt.pm * tstep : cA; const char* nB = has_next ? (const char*)g.Bt + (size_t)nxt.pn * tstep : cB;
        for (int t = 0; t < nt; t += 2) {
            const bool last = (t == nt - 2);
            const char* a1 = cA + (size_t)(t + 1) * kstep;
            const char* a2 = last ? nA : cA + (size_t)(t + 2) * kstep; const char* b2 = last ? nB : cB + (size_t)(t + 2) * kstep;
            const char* a3 = a2 + kstep; const char* b3 = b2 + kstep;
            if (last && has_next) S.a_ready(nxt);
            if constexpr (SP2) {
            PG8_LDB(B0, 0, 0); PG8_LDB(B1, 0, 1); PG8_SCHED; PG8_LDA(At, 0, 0); PG8_STAGE(PG8_SA(1, 1), a1 + hstep, voffA);
            PG8_WAIT_V(8); PG8_WAIT_L(0); PG8_BAR; PG8_MMA(0, 0, At, B0); PG8_MMA(0, 1, At, B1); PG8_BAR; PG8_SCHED;
            PG8_LDA(At, 0, 1); PG8_STAGE(PG8_SB(0, 0), b2, voffB); PG8_STAGE(PG8_SB(0, 1), b2 + hstep, voffB); PG8_STAGE(PG8_SA(0, 0), a2, voffA);
            PG8_WAIT_V(8); PG8_WAIT_L(0); PG8_BAR; PG8_MMA(1, 0, At, B0); PG8_MMA(1, 1, At, B1); PG8_BAR; PG8_SCHED;
            PG8_LDB(B0, 1, 0); PG8_LDB(B1, 1, 1); PG8_SCHED; PG8_LDA(At, 1, 0); PG8_STAGE(PG8_SA(0, 1), a2 + hstep, voffA);
            PG8_WAIT_V(8); PG8_WAIT_L(0); PG8_BAR; PG8_MMA(0, 0, At, B0); PG8_MMA(0, 1, At, B1); PG8_BAR; PG8_SCHED;
            PG8_LDA(At, 1, 1); PG8_STAGE(PG8_SB(1, 0), b3, voffB); PG8_STAGE(PG8_SB(1, 1), b3 + hstep, voffB); PG8_STAGE(PG8_SA(1, 0), a3, voffA);
            PG8_WAIT_V(8); PG8_WAIT_L(0); PG8_BAR; PG8_MMA(1, 0, At, B0); PG8_MMA(1, 1, At, B1); PG8_BAR; PG8_SCHED;
            } else {
            PG8_LDB(B0, 0, 0); PG8_SCHED; PG8_LDA(At, 0, 0); PG8_STAGE(PG8_SA(1, 1), a1 + hstep, voffA);
            PG8_WAIT_L(8); PG8_BAR; PG8_WAIT_L(0); PG8_MMA(0, 0, At, B0); PG8_BAR; PG8_SCHED;
            PG8_LDB(B1, 0, 1); PG8_STAGE(PG8_SB(0, 0), b2, voffB);
            PG8_BAR; PG8_WAIT_L(0); PG8_MMA(0, 1, At, B1); PG8_BAR;
            PG8_LDA(At, 0, 1); PG8_STAGE(PG8_SA(0, 0), a2, voffA);
            PG8_BAR; PG8_WAIT_L(0); PG8_MMA(1, 0, At, B0); PG8_BAR; PG8_SCHED;
            PG8_STAGE(PG8_SB(0, 1), b2 + hstep, voffB);
            PG8_WAIT_V(6); PG8_BAR; PG8_MMA(1, 1, At, B1); PG8_BAR;
            PG8_LDB(B0, 1, 0); PG8_SCHED; PG8_LDA(At, 1, 0); PG8_STAGE(PG8_SA(0, 1), a2 + hstep, voffA);
            PG8_WAIT_L(8); PG8_BAR; PG8_WAIT_L(0); PG8_MMA(0, 0, At, B0); PG8_BAR; PG8_SCHED;
            PG8_LDB(B1, 1, 1); PG8_STAGE(PG8_SB(1, 0), b3, voffB);
            PG8_BAR; PG8_WAIT_L(0); PG8_MMA(0, 1, At, B1); PG8_BAR;
            PG8_LDA(At, 1, 1); PG8_STAGE(PG8_SA(1, 0), a3, voffA);
            PG8_BAR; PG8_WAIT_L(0); PG8_MMA(1, 0, At, B0); PG8_BAR; PG8_SCHED;
            PG8_STAGE(PG8_SB(1, 1), b3 + hstep, voffB);
            PG8_WAIT_V(6); PG8_BAR; PG8_MMA(1, 1, At, B1); PG8_BAR;
            }
        }
        if constexpr (ALIGN_EPI) { if (wr == 0) PG8_BAR; }
        if constexpr (!Epi::AFTER_DRAIN) { E(acc, cur, wr, wc, fr, fq); S.done(cur); }
        if (!has_next) break;
        bool keep_acc = false;
        if constexpr (Epi::KEEP) keep_acc = E.keep(cur);
        if (!keep_acc) {
#pragma unroll
        for (int a = 0; a < 2; ++a)
#pragma unroll
            for (int b = 0; b < 2; ++b)
#pragma unroll
                for (int m = 0; m < 4; ++m)
#pragma unroll
                    for (int n = 0; n < 2; ++n) acc[a][b][m][n] = (f32x4){0.f, 0.f, 0.f, 0.f};
        }
        cur = nxt; cA = nA; cB = nB; ++ui;
        if constexpr (ALIGN_EPI) { if (wr == 1) PG8_BAR; }
    }
    PG8_WAIT_V(0);
    if constexpr (!ALIGN_EPI) { if (wr == 0) PG8_BAR; }
    PG8_BAR;
    if constexpr (Epi::AFTER_DRAIN) { E.fused(acc, cur, wr, wc, fr, fq, lds, wid, lane); S.done(cur); }
#undef PG8_SA
#undef PG8_SB
#undef PG8_STAGE
#undef PG8_LDA
#undef PG8_LDB
#undef PG8_MMA
#undef PG8_WAIT_V
#undef PG8_WAIT_L
#undef PG8_BAR
#undef PG8_SCHED
}
}

#define LAS __attribute__((address_space(3)))
typedef unsigned short bf16_t;
typedef short bf16x8 __attribute__((ext_vector_type(8)));
typedef short s16x4 __attribute__((ext_vector_type(4)));
typedef float f32x16 __attribute__((ext_vector_type(16)));
typedef float f32x4 __attribute__((ext_vector_type(4)));
typedef float f32x2 __attribute__((ext_vector_type(2)));
typedef unsigned u32x4 __attribute__((ext_vector_type(4)));
typedef unsigned u32x2 __attribute__((ext_vector_type(2)));

constexpr int DM = 1024, NBATCH = 8, SEQ = 2048, MTOK = NBATCH * SEQ, DEPTH = 4, NIN = 5912, NINP = 6144;
constexpr float RMS_EPS = 1e-6f, NEGF = -1e30f;
constexpr size_t MiB = 1u << 20;
constexpr size_t WS_MOD = 0;
constexpr size_t WS_BAR = 768 * 1024;
constexpr size_t WS_B1P = 512 * 1024;
constexpr size_t WS_B1 = 640 * 1024;
constexpr size_t WS_ROPE = 1 * MiB;
constexpr size_t WS_W2T = 2 * MiB;
constexpr size_t WS_KC = 2 * MiB + 256 * 1024;
constexpr size_t WS_VC = 2 * MiB + 512 * 1024;
constexpr size_t WS_NG = 3 * MiB;
constexpr size_t WS_W1T = 5 * MiB;
constexpr size_t WS_WABT = 9 * MiB;
constexpr size_t WS_WOT = 17 * MiB;
constexpr size_t WS_WINT = 25 * MiB;
constexpr size_t WS_H = 73 * MiB;
constexpr size_t WS_Y = WS_H;
constexpr size_t WS_SBQ = 105 * MiB, WS_SBK = 121 * MiB, WS_SBV = 137 * MiB, WS_NQ = 153 * MiB;
constexpr size_t WS_YA = WS_SBQ;
constexpr size_t WS_SBZ = 169 * MiB, WS_NZ = 185 * MiB;
constexpr size_t WS_MA = 201 * MiB, WS_MB = 233 * MiB;
constexpr size_t WS_KCR = 265 * MiB, WS_VCR = 269 * MiB, WS_KS = 273 * MiB, WS_VS = 277 * MiB, WS_KW = 281 * MiB, WS_VW = 285 * MiB;
constexpr size_t WS_AACT = 289 * MiB, WS_BACT = 305 * MiB;
constexpr size_t WS_SSQ = 321 * MiB;
constexpr size_t WS_END = 322 * MiB;
constexpr int LDS_BYTES = 131072 + 4096;

#ifndef PROBE_K
#define PROBE_K 99
#define PROBE_N 1
#endif
struct Args { const float* in[19]; float* out; unsigned char* ws; int ph_lo, ph_hi, use_cg, pad; };

__device__ __forceinline__ unsigned f2bf(float f) { unsigned u = __builtin_bit_cast(unsigned, f); return (u + 0x7fffu + ((u >> 16) & 1u)) >> 16; }
typedef __bf16 bf16x2_t __attribute__((ext_vector_type(2)));
__device__ __forceinline__ unsigned pk2(float lo, float hi) { f32x2 v = {lo, hi}; bf16x2_t b = __builtin_convertvector(v, bf16x2_t); return __builtin_bit_cast(unsigned, b); }
__device__ __forceinline__ float bf_lo(unsigned w) { return __builtin_bit_cast(float, w << 16); }
__device__ __forceinline__ float bf_hi(unsigned w) { return __builtin_bit_cast(float, w & 0xffff0000u); }
__device__ __forceinline__ float sigmoidf_(float x) { return __builtin_amdgcn_rcpf(1.0f + __expf(-x)); }
__device__ __forceinline__ float siluf_(float x) { return x * sigmoidf_(x); }
__device__ __forceinline__ float wave_sum(float v) {
#pragma unroll
    for (int o = 1; o < 64; o <<= 1) v += __shfl_xor(v, o);
    return v;
}
#define LDS_WAIT() asm volatile("s_waitcnt lgkmcnt(0)" ::: "memory")
__device__ __forceinline__ void st16_wt(void* p, u32x4 v) { *(u32x4*)p = v; }
__device__ __forceinline__ void st8_wt(void* p, u32x2 v) { *(u32x2*)p = v; }
constexpr float QSCALE = 0.125f * 1.4426950408889634f;

struct TItem { const float* W; bf16_t* WT; int ldw, n0, nv, K, k0, drow, frag; };
__device__ __forceinline__ void titem_load(const TItem& t, float (&tv)[32], int lane) {
    const int cidx = lane & 31;
#pragma unroll
    for (int i = 0; i < 32; ++i) { const int kk = 2 * i + (lane >> 5); tv[i] = 0.f; if (cidx < t.nv) tv[i] = t.W[(size_t)(t.k0 + kk) * t.ldw + t.n0 + cidx]; }
}
__device__ __forceinline__ void titem_finish(const TItem& t, const float (&tv)[32], LAS float* scr, int lane) {
    const int cidx = lane & 31;
#pragma unroll
    for (int i = 0; i < 32; ++i) { const int kk = 2 * i + (lane >> 5); scr[kk * 33 + cidx] = tv[i]; }
    LDS_WAIT();
    const int c = lane & 7;
#pragma unroll
    for (int j = 0; j < 4; ++j) { const int n = (lane >> 3) + 8 * j; const LAS float* sp = scr + (8 * c) * 33 + n;
        u32x4 o; o.x = pk2(sp[0 * 33], sp[1 * 33]); o.y = pk2(sp[2 * 33], sp[3 * 33]); o.z = pk2(sp[4 * 33], sp[5 * 33]); o.w = pk2(sp[6 * 33], sp[7 * 33]);
        size_t dsto = (size_t)(t.drow + n) * t.K + t.k0 + 8 * c;
        if (t.frag) { const int ng = t.drow + n, k = t.k0 + 8 * c;
            dsto = (size_t)((((((ng >> 6) * 4 + ((ng >> 4) & 3)) * 4 + (k >> 9)) * 16 + ((k >> 5) & 15)) * 64 + ((k >> 3) & 3) * 16 + (ng & 15))) * 8; }
        *(u32x4*)(t.WT + dsto) = o; }
    LDS_WAIT();
}
__device__ __forceinline__ TItem titem_decode(const Args& a, unsigned char* ws, int it) {
    constexpr int I_IN = 4 * 96 * 2 * 16, I_AB = 2 * 4 * 8 * 32, I_O = 4 * 16 * 32, I_1 = 8 * 32 * 4;
    TItem t; t.frag = 0; int r = it;
    if (r < I_IN) {
        const int l = r / 3072; r %= 3072; const int H = r >> 5, hh = (r >> 4) & 1, kb = r & 15;
        int srcb, nv = 32;
        if (H < 60) srcb = 64 * H; else if (H < 76) srcb = 3864 + 64 * (H - 60); else if (H < 92) srcb = 4888 + 64 * (H - 76); else { srcb = 3840; nv = (H == 92 && hh == 0) ? 24 : 0; }
        t.W = a.in[5] + (size_t)l * 1024 * NIN; t.ldw = NIN; t.n0 = srcb + 32 * hh; t.nv = nv; t.WT = (bf16_t*)(ws + WS_WINT) + (size_t)l * NINP * 1024; t.K = 1024; t.k0 = 64 * kb; t.drow = 256 * (H >> 2) + 128 * hh + 32 * (H & 3);
        return t;
    }
    r -= I_IN;
    if (r < I_AB) {
        const int which = r / 1024; r %= 1024; const int l = r / 256; r %= 256; const int kb = r / 32, nb = r % 32;
        t.W = a.in[which ? 17 : 16] + (size_t)l * 512 * 1024; t.ldw = 1024; t.n0 = 32 * nb; t.nv = 32; t.WT = (bf16_t*)(ws + WS_WABT) + (size_t)l * 2048 * 512; t.K = 512; t.k0 = 64 * kb; t.drow = 1024 * which + 32 * nb;
        return t;
    }
    r -= I_AB;
    if (r < I_O) {
        const int l = r / 512; r %= 512; const int kb = r / 32, nb = r % 32;
        t.W = a.in[18] + (size_t)l * 1024 * 1024; t.ldw = 1024; t.n0 = 32 * nb; t.nv = 32; t.WT = (bf16_t*)(ws + WS_WOT) + (size_t)l * 1024 * 1024; t.K = 1024; t.k0 = 64 * kb; t.drow = 32 * nb;
        return t;
    }
    r -= I_O;
    if (r < I_1) {
        const int lk = r / 128; r %= 128; const int kb = r / 4, nb = r % 4; const int l = lk >> 1, kv = lk & 1;
        t.W = a.in[kv ? 14 : 11] + (size_t)l * 2048 * 128; t.ldw = 128; t.n0 = 32 * nb; t.nv = 32; t.WT = (bf16_t*)(ws + WS_W1T) + (size_t)lk * 128 * 2048; t.K = 2048; t.k0 = 64 * kb; t.drow = 32 * nb; t.frag = 1;
        return t;
    }
    r -= I_1;
    { const int lk = r / 4; r %= 4; const int kb = r / 2, nb = r % 2; const int l = lk >> 1, kv = lk & 1;
      t.W = a.in[kv ? 15 : 12] + (size_t)l * 128 * 64; t.ldw = 64; t.n0 = 32 * nb; t.nv = 32; t.WT = (bf16_t*)(ws + WS_W2T) + (size_t)lk * 64 * 128; t.K = 128; t.k0 = 64 * kb; t.drow = 32 * nb; }
    return t;
}

__device__ __forceinline__ void phase0(const Args& a, unsigned char* ws, LAS unsigned char* L, int tid, int lane, int wid) {
    {
        LAS float* sc = (LAS float*)L; LAS float* red = (LAS float*)(L + 32768);
        const float* c = a.in[1]; const float* ada_w = a.in[2]; const float* ada_b = a.in[3]; float* mod = (float*)(ws + WS_MOD);
        if ((int)blockIdx.x < 192) {
            for (int i = tid; i < 8192; i += 512) sc[i] = siluf_(c[i]);
            __syncthreads();
        }
        for (int u = blockIdx.x; u < 192; u += gridDim.x) {
            const int l = u / 48, cgp = u % 48, col = cgp * 64 + (tid & 63), ks = tid >> 6;
            float acc[8];
#pragma unroll
            for (int b = 0; b < 8; ++b) acc[b] = 0.f;
            const float* wp = ada_w + ((size_t)l * 1024 + ks * 128) * 3072 + col;
#pragma unroll 16
            for (int k = 0; k < 128; ++k) { const float w = wp[(size_t)k * 3072];
#pragma unroll
                for (int b = 0; b < 8; ++b) acc[b] += sc[b * 1024 + ks * 128 + k] * w; }
#pragma unroll
            for (int b = 0; b < 8; ++b) red[(ks * 8 + b) * 64 + (tid & 63)] = acc[b];
            __syncthreads();
            { const int b = tid >> 6, cc = tid & 63; float s = 0.f;
#pragma unroll
              for (int k2 = 0; k2 < 8; ++k2) s += red[(k2 * 8 + b) * 64 + cc];
              mod[((size_t)l * 8 + b) * 3072 + cgp * 64 + cc] = s + ada_b[l * 3072 + cgp * 64 + cc]; }
            __syncthreads();
        }
    }
    {
        __syncthreads();
        LAS float* redb = (LAS float*)(L + 32768);
        for (int u = (int)gridDim.x - 1 - (int)blockIdx.x; u < 128; u += gridDim.x) {
            const int lk = u >> 4, sl = u & 15, l = lk >> 1, kv = lk & 1, hcol = tid & 127, sub = tid >> 7;
            const float* pe = a.in[kv ? 13 : 10] + (size_t)l * 2048 + sl * 128 + sub * 32; const float* w1 = a.in[kv ? 14 : 11] + ((size_t)l * 2048 + sl * 128 + sub * 32) * 128 + hcol;
            float acc = 0.f;
#pragma unroll 16
            for (int f = 0; f < 32; ++f) acc += pe[f] * w1[(size_t)f * 128];
            redb[sub * 128 + hcol] = acc;
            __syncthreads();
            if (tid < 128) ((float*)(ws + WS_B1P))[(lk * 16 + sl) * 128 + tid] = (redb[tid] + redb[128 + tid]) + (redb[256 + tid] + redb[384 + tid]);
            __syncthreads();
        }
    }
    {
        LAS float* scr = (LAS float*)(L + 49152 + wid * 8448);
        const int gw = blockIdx.x * 8 + wid, NGW = gridDim.x * 8;
        constexpr int NITEMS = 4 * 96 * 2 * 16 + 2 * 4 * 8 * 32 + 4 * 16 * 32 + 8 * 32 * 4 + 8 * 2 * 2;
        int it = gw, istride = NGW, iend = NITEMS;
        if (gridDim.x == 256) {
            if (blockIdx.x < 192) { istride = 1536; iend = 11520; } else { it = 11520 + ((int)blockIdx.x - 192) * 8 + wid; istride = 512; }
        }
        if (it < iend) {
            TItem cur = titem_decode(a, ws, it); float tva[32]; titem_load(cur, tva, lane);
            for (;;) {
                const int nit = it + istride; const bool more = nit < iend;
                TItem nxt = cur; float tvb[32];
                if (more) { nxt = titem_decode(a, ws, nit); titem_load(nxt, tvb, lane); }
                titem_finish(cur, tva, scr, lane);
                if (!more) break;
                cur = nxt; it = nit;
#pragma unroll
                for (int i = 0; i < 32; ++i) tva[i] = tvb[i];
            }
        }
    }
    {
        f32x2* rope = (f32x2*)(ws + WS_ROPE);
        for (int e = blockIdx.x * 512 + tid; e < 2048 * 32; e += gridDim.x * 512) {
            const int t = e >> 5, i = e & 31;
            double fr = 1.0; for (int k = 0; k < i; ++k) fr *= 0.7498942093324559;
            const float freq = (float)fr; const float ang = (float)t * freq;
            const double x = (double)ang; const double kq = __builtin_rint(x * 0.15915494309189535); const double rr = x - kq * 6.283185307179586;
            const double y = 0.5 * rr, y2 = y * y;
            double sp = 2.8114572543455206e-15; sp = sp * y2 - 7.647163731819816e-13; sp = sp * y2 + 1.6059043836821613e-10; sp = sp * y2 - 2.505210838544172e-08; sp = sp * y2 + 2.7557319223985893e-06;
            sp = sp * y2 - 0.0001984126984126984; sp = sp * y2 + 0.008333333333333333; sp = sp * y2 - 0.16666666666666666; sp = sp * y2 + 1.0; const double s = sp * y;
            double cp = 1.5619206968586225e-16; cp = cp * y2 - 4.779477332387385e-14; cp = cp * y2 + 1.1470745597729725e-11; cp = cp * y2 - 2.08767569878681e-09; cp = cp * y2 + 2.755731922398589e-07;
            cp = cp * y2 - 2.48015873015873e-05; cp = cp * y2 + 0.001388888888888889; cp = cp * y2 - 0.041666666666666664; cp = cp * y2 + 0.5; const double c = 1.0 - cp * y2;
            f32x2 o; o.x = (float)(1.0 - 2.0 * s * s); o.y = (float)(2.0 * s * c); rope[e] = o;
        }
    }
}

__device__ __forceinline__ void phase1(const Args& a, unsigned char* ws, const float* xin, int l, int lane, int row_first, int row_step, int row_end) {
    const float* g = a.in[4] + l * 1024; const float* mod = (const float*)(ws + WS_MOD) + (size_t)l * 8 * 3072; bf16_t* H = (bf16_t*)(ws + WS_H);
    for (int row0 = row_first; row0 < row_end; row0 += 4 * row_step) {
        f32x4 v[4][4]; float ss[4];
#pragma unroll
        for (int q = 0; q < 4; ++q) { const f32x4* xr = (const f32x4*)(xin + (size_t)(row0 + q * row_step) * 1024) + lane;
#pragma unroll
            for (int j = 0; j < 4; ++j) v[q][j] = xr[64 * j]; }
#pragma unroll
        for (int q = 0; q < 4; ++q) { float sq = 0.f;
#pragma unroll
            for (int j = 0; j < 4; ++j) sq += (v[q][j].x * v[q][j].x + v[q][j].y * v[q][j].y) + (v[q][j].z * v[q][j].z + v[q][j].w * v[q][j].w);
            ss[q] = 1.0f / sqrtf(wave_sum(sq) * (1.0f / 1024.0f) + RMS_EPS); }
#pragma unroll
        for (int j = 0; j < 4; ++j) { const int k = 256 * j + 4 * lane; const f32x4 gg = *(const f32x4*)(g + k);
#pragma unroll
            for (int q = 0; q < 4; ++q) { const int row = row0 + q * row_step; const float* mb = mod + (size_t)(row >> 11) * 3072;
                const f32x4 sh = *(const f32x4*)(mb + k), scl = *(const f32x4*)(mb + 1024 + k); const f32x4 y = (v[q][j] * ss[q]) * gg * (scl + 1.0f) + sh;
                u32x2 w; w.x = pk2(y.x, y.y); w.y = pk2(y.z, y.w); ((u32x2*)(H + (size_t)row * 1024) + lane)[64 * j] = w; } }
    }
}

__device__ __forceinline__ bf16_t* hm_base(unsigned char* ws, size_t off, int b, int nh, int head) { return (bf16_t*)(ws + off) + ((size_t)(b * (nh - 1) + head)) * 2048 * 64; }
struct EpiIn {
    static constexpr bool PERM = true, AFTER_DRAIN = false, KEEP = false, INIT = false;
    unsigned char* ws; const float* qg; const float* ksg; const float* kwg;
    __device__ __forceinline__ void operator()(const pg8::f32x4 (&acc)[2][2][4][2], const pg8::Unit& u, int wr, int wc, int fr, int fq) const {
        const int H = u.pn * 4 + wc;
        if (H >= 93) return;
        const int b = u.pm >> 3; const int rowb = u.pm * 256 + wr * 64 + fr;
        if (H == 92) {
            float* ng = (float*)(ws + WS_NG);
            if (fq < 3) {
#pragma unroll
                for (int ai = 0; ai < 2; ++ai)
#pragma unroll
                    for (int m = 0; m < 4; ++m) { const int r = rowb + 128 * ai + 16 * m;
#pragma unroll
                        for (int n = 0; n < 2; ++n) { const pg8::f32x4 v = acc[ai][0][m][n]; f32x4 o; o.x = sigmoidf_(v[0]); o.y = sigmoidf_(v[1]); o.z = sigmoidf_(v[2]); o.w = sigmoidf_(v[3]);
                            *(f32x4*)(ng + (size_t)r * 24 + 8 * fq + 4 * n) = o; } }
            }
            return;
        }
        bf16_t* base; int ld = 64, act = 0; const float* g = nullptr; bool klay = false, clay = false;
        if (H < 8) { base = hm_base(ws, WS_SBQ, b, 8, H); act = 3; }
        else if (H < 16) { base = hm_base(ws, WS_SBK, b, 8, H - 8); klay = true; }
        else if (H < 24) base = hm_base(ws, WS_SBV, b, 8, H - 16);
        else if (H < 32) { base = (bf16_t*)(ws + WS_SBZ) + (H - 24) * 64; ld = 512; act = 1; }
        else if (H < 40) { base = hm_base(ws, WS_NQ, b, 8, H - 32); act = 3; g = qg; }
        else if (H < 42) { base = hm_base(ws, WS_KCR, b, 2, H - 40); clay = true; }
        else if (H < 44) { base = hm_base(ws, WS_VCR, b, 2, H - 42); clay = true; }
        else if (H < 46) { base = hm_base(ws, WS_KS, b, 2, H - 44); g = ksg; }
        else if (H < 48) base = hm_base(ws, WS_VS, b, 2, H - 46);
        else if (H < 50) { base = hm_base(ws, WS_KW, b, 2, H - 48); g = kwg; }
        else if (H < 52) base = hm_base(ws, WS_VW, b, 2, H - 50);
        else if (H < 60) { base = (bf16_t*)(ws + WS_NZ) + (H - 52) * 64; ld = 512; act = 1; }
        else if (H < 76) { base = (bf16_t*)(ws + WS_MA) + (H - 60) * 64; ld = 1024; act = 2; }
        else { base = (bf16_t*)(ws + WS_MB) + (H - 76) * 64; ld = 1024; act = 2; }
        const f32x2* rope = (const f32x2*)(ws + WS_ROPE);
#pragma unroll
        for (int ai = 0; ai < 2; ++ai)
#pragma unroll
            for (int m = 0; m < 4; ++m) {
                const int r = rowb + 128 * ai + 16 * m;
                float v[16];
#pragma unroll
                for (int bj = 0; bj < 2; ++bj)
#pragma unroll
                    for (int n = 0; n < 2; ++n)
#pragma unroll
                        for (int j = 0; j < 4; ++j) v[bj * 8 + n * 4 + j] = acc[ai][bj][m][n][j];
                if (g) {
                    float ss = 0.f;
#pragma unroll
                    for (int i = 0; i < 16; ++i) ss += v[i] * v[i];
                    ss += __shfl_xor(ss, 16); ss += __shfl_xor(ss, 32);
                    const float rstd = 1.0f / sqrtf(ss * (1.0f / 64.0f) + RMS_EPS);
                    const f32x2* rp = rope + (size_t)(r & 2047) * 32 + 8 * fq;
#pragma unroll
                    for (int i = 0; i < 8; ++i) { const float x1 = v[i] * rstd * g[8 * fq + i], x2 = v[8 + i] * rstd * g[32 + 8 * fq + i]; const f32x2 cs = rp[i];
                        v[i] = x1 * cs.x - x2 * cs.y; v[8 + i] = x2 * cs.x + x1 * cs.y; }
                }
                if (act == 1) {
#pragma unroll
                    for (int i = 0; i < 16; ++i) v[i] = siluf_(v[i]);
                } else if (act == 2) {
#pragma unroll
                    for (int i = 0; i < 16; ++i) v[i] = sigmoidf_(v[i]);
                } else if (act == 3) {
#pragma unroll
                    for (int i = 0; i < 16; ++i) v[i] *= QSCALE;
                }
                bf16_t* rowp = base + (size_t)r * ld + 8 * fq;
                if (klay) { const int s_ = r & 2047;
                    rowp = base + (size_t)(r - s_) * 64 + (size_t)(s_ >> 6) * 4096 + ((((fq >> 1) * 2 + ((s_ >> 5) & 1)) * 32 + (s_ & 31)) * 2 + (fq & 1)) * 8; }
                u32x4 w0, w1; w0.x = pk2(v[0], v[1]); w0.y = pk2(v[2], v[3]); w0.z = pk2(v[4], v[5]); w0.w = pk2(v[6], v[7]);
                w1.x = pk2(v[8], v[9]); w1.y = pk2(v[10], v[11]); w1.z = pk2(v[12], v[13]); w1.w = pk2(v[14], v[15]);
                if (clay) { const int s_ = r & 2047; rowp = base + (size_t)(r - s_) * 64 + (size_t)((s_ & 15) * 128 + (s_ >> 4)) * 32 + 8 * fq; }
                st16_wt(rowp, w0); st16_wt(rowp + (klay ? 2048 : (clay ? 65536 : 32)), w1);
            }
    }
};
template <int MODE  > struct EpiOut {
    static constexpr bool PERM = false, AFTER_DRAIN = false, KEEP = false, INIT = false;
    unsigned char* ws; const float* xin; float* out; const float* gate;
    __device__ __forceinline__ void operator()(const pg8::f32x4 (&acc)[2][2][4][2], const pg8::Unit& u, int wr, int wc, int fr, int fq) const {
        const int rowb = u.pm * 256 + wr * 64 + fr, colb = u.pn * 256 + wc * 32 + 4 * fq; const int b = u.pm >> 3;
#pragma unroll
        for (int ai = 0; ai < 2; ++ai)
#pragma unroll
            for (int m = 0; m < 4; ++m) { const size_t r = rowb + 128 * ai + 16 * m;
#pragma unroll
                for (int bj = 0; bj < 2; ++bj)
#pragma unroll
                    for (int n = 0; n < 2; ++n) { const int c = colb + 128 * bj + 16 * n; const pg8::f32x4 v = acc[ai][bj][m][n];
                        if (MODE == 0) { const u32x2 mw = *(const u32x2*)((const bf16_t*)(ws + WS_MA) + r * 1024 + c);
                            u32x2 o; o.x = pk2(v[0] * bf_lo(mw.x), v[1] * bf_hi(mw.x)); o.y = pk2(v[2] * bf_lo(mw.y), v[3] * bf_hi(mw.y)); *(u32x2*)((bf16_t*)(ws + WS_YA) + r * 1024 + c) = o; }
                        else if (MODE == 1) { const u32x2 mw = *(const u32x2*)((const bf16_t*)(ws + WS_MB) + r * 1024 + c); const u32x2 ya = *(const u32x2*)((const bf16_t*)(ws + WS_YA) + r * 1024 + c);
                            u32x2 o; o.x = pk2(bf_lo(ya.x) + v[0] * bf_lo(mw.x), bf_hi(ya.x) + v[1] * bf_hi(mw.x)); o.y = pk2(bf_lo(ya.y) + v[2] * bf_lo(mw.y), bf_hi(ya.y) + v[3] * bf_hi(mw.y)); st8_wt((bf16_t*)(ws + WS_Y) + r * 1024 + c, o); }
                        else { const f32x4 xv = *(const f32x4*)(xin + r * 1024 + c), gv = *(const f32x4*)(gate + (size_t)b * 3072 + c);
                            f32x4 o; o.x = xv.x + gv.x * v[0]; o.y = xv.y + gv.y * v[1]; o.z = xv.z + gv.z * v[2]; o.w = xv.w + gv.w * v[3]; st16_wt(out + r * 1024 + c, __builtin_bit_cast(u32x4, o)); } }
            }
    }
};

struct EpiOutNorm {
    static constexpr bool PERM = true, AFTER_DRAIN = true, KEEP = false, INIT = true;
    unsigned char* ws; const float* xin; float* out; const float* gate; const float* gnext; const float* modnext; unsigned* cnt; int fuse;
    static __device__ __forceinline__ float gate_c(float g) { return __builtin_fabsf(g) < 8.673617e-19f ? __builtin_copysignf(8.673617e-19f, g) : g; }
    __device__ __forceinline__ void init_load(pg8::f32x4 (&acc)[2][2][4][2], const pg8::Unit& u, int wr, int wc, int fr, int fq) const {
        const int rowb = u.pm * 256 + wr * 64 + fr, colb = u.pn * 256 + wc * 32 + 8 * fq;
#pragma unroll
        for (int ai = 0; ai < 2; ++ai)
#pragma unroll
            for (int m = 0; m < 4; ++m) { const size_t r = rowb + 128 * ai + 16 * m;
#pragma unroll
                for (int bj = 0; bj < 2; ++bj)
#pragma unroll
                    for (int n = 0; n < 2; ++n) { const f32x4 xv = *(const f32x4*)(xin + r * 1024 + colb + 128 * bj + 4 * n); pg8::f32x4& v = acc[ai][bj][m][n]; v[0] = xv.x; v[1] = xv.y; v[2] = xv.z; v[3] = xv.w; } }
    }
    __device__ __forceinline__ void init_scale(pg8::f32x4 (&acc)[2][2][4][2], const pg8::Unit& u, int wr, int wc, int fr, int fq) const {
        const int colb = u.pn * 256 + wc * 32 + 8 * fq; const int b = u.pm >> 3;
#pragma unroll
        for (int bj = 0; bj < 2; ++bj)
#pragma unroll
            for (int n = 0; n < 2; ++n) { const f32x4 gv = *(const f32x4*)(gate + (size_t)b * 3072 + colb + 128 * bj + 4 * n);
                const float r0 = __builtin_amdgcn_rcpf(gate_c(gv.x)), r1 = __builtin_amdgcn_rcpf(gate_c(gv.y)), r2 = __builtin_amdgcn_rcpf(gate_c(gv.z)), r3 = __builtin_amdgcn_rcpf(gate_c(gv.w));
#pragma unroll
                for (int ai = 0; ai < 2; ++ai)
#pragma unroll
                    for (int m = 0; m < 4; ++m) { pg8::f32x4& v = acc[ai][bj][m][n]; v[0] *= r0; v[1] *= r1; v[2] *= r2; v[3] *= r3; } }
    }
    __device__ __forceinline__ void fused(pg8::f32x4 (&acc)[2][2][4][2], const pg8::Unit& u, int wr, int wc, int fr, int fq, PG8_LAS unsigned char* lds, int wid, int lane) const {
        const int rowb = u.pm * 256 + wr * 64 + fr, colb = u.pn * 256 + wc * 32 + 8 * fq; const int b = u.pm >> 3;
        float* ssq = (float*)(ws + WS_SSQ);
#pragma unroll
        for (int ai = 0; ai < 2; ++ai)
#pragma unroll
            for (int m = 0; m < 4; ++m) { const size_t r = rowb + 128 * ai + 16 * m; float sq = 0.f;
#pragma unroll
                for (int bj = 0; bj < 2; ++bj)
#pragma unroll
                    for (int n = 0; n < 2; ++n) { const int c = colb + 128 * bj + 4 * n; const f32x4 gv = *(const f32x4*)(gate + (size_t)b * 3072 + c);
                        pg8::f32x4& v = acc[ai][bj][m][n]; v[0] = gate_c(gv.x) * v[0]; v[1] = gate_c(gv.y) * v[1]; v[2] = gate_c(gv.z) * v[2]; v[3] = gate_c(gv.w) * v[3];
                        f32x4 o; o.x = v[0]; o.y = v[1]; o.z = v[2]; o.w = v[3]; *(f32x4*)(out + r * 1024 + c) = o;
                        sq += (v[0] * v[0] + v[1] * v[1]) + (v[2] * v[2] + v[3] * v[3]); }
                if (fuse) { sq += __shfl_xor(sq, 16); sq += __shfl_xor(sq, 32); if (fq == 0) __hip_atomic_store(ssq + r * 16 + u.pn * 4 + wc, sq, __ATOMIC_RELAXED, __HIP_MEMORY_SCOPE_AGENT); }
            }
        if (!fuse) return;
        asm volatile("s_waitcnt vmcnt(0)" ::: "memory");
        __builtin_amdgcn_s_barrier(); asm volatile("" ::: "memory");
        if (wid == 0 && lane == 0) {
            unsigned* c = cnt + u.pm; unsigned sp = 0;
            __hip_atomic_fetch_add(c, 1u, __ATOMIC_RELAXED, __HIP_MEMORY_SCOPE_AGENT);
            while (__hip_atomic_load(c, __ATOMIC_RELAXED, __HIP_MEMORY_SCOPE_AGENT) < 4u) { __builtin_amdgcn_s_sleep(1); if (++sp > (1u << 22)) break; }
        }
        asm volatile("" ::: "memory"); __builtin_amdgcn_s_barrier(); asm volatile("" ::: "memory");
        PG8_LAS float* S = (PG8_LAS float*)lds;
        { const int t = wid * 64 + lane;
          if (t < 256) { float* pp = ssq + (size_t)(u.pm * 256 + t) * 16; float pv_[16];
#pragma unroll
              for (int q = 0; q < 16; ++q) pv_[q] = __hip_atomic_load(pp + q, __ATOMIC_RELAXED, __HIP_MEMORY_SCOPE_AGENT);
              const float tot = (((pv_[0] + pv_[1]) + (pv_[2] + pv_[3])) + ((pv_[4] + pv_[5]) + (pv_[6] + pv_[7]))) + (((pv_[8] + pv_[9]) + (pv_[10] + pv_[11])) + ((pv_[12] + pv_[13]) + (pv_[14] + pv_[15])));
              S[t] = 1.0f / sqrtf(tot * (1.0f / 1024.0f) + RMS_EPS); } }
        asm volatile("s_waitcnt lgkmcnt(0)" ::: "memory"); __builtin_amdgcn_s_barrier(); asm volatile("" ::: "memory");
        bf16_t* H = (bf16_t*)(ws + WS_H); const float* mb = modnext + (size_t)b * 3072;
#pragma unroll
        for (int bj = 0; bj < 2; ++bj) { const int c = colb + 128 * bj;
            const f32x4 g0 = *(const f32x4*)(gnext + c), g1 = *(const f32x4*)(gnext + c + 4), s0 = *(const f32x4*)(mb + c), s1 = *(const f32x4*)(mb + c + 4), q0 = *(const f32x4*)(mb + 1024 + c), q1 = *(const f32x4*)(mb + 1024 + c + 4);
            const f32x4 m0 = g0 * (q0 + 1.0f), m1 = g1 * (q1 + 1.0f);
#pragma unroll
            for (int ai = 0; ai < 2; ++ai)
#pragma unroll
                for (int m = 0; m < 4; ++m) { const int rl = 128 * ai + wr * 64 + 16 * m + fr; const float rs = S[rl]; const size_t r = (size_t)u.pm * 256 + rl;
                    const pg8::f32x4 v0 = acc[ai][bj][m][0], v1 = acc[ai][bj][m][1];
                    u32x4 w; w.x = pk2(v0[0] * rs * m0.x + s0.x, v0[1] * rs * m0.y + s0.y); w.y = pk2(v0[2] * rs * m0.z + s0.z, v0[3] * rs * m0.w + s0.w);
                    w.z = pk2(v1[0] * rs * m1.x + s1.x, v1[1] * rs * m1.y + s1.y); w.w = pk2(v1[2] * rs * m1.z + s1.z, v1[3] * rs * m1.w + s1.w);
                    *(u32x4*)(H + r * 1024 + c) = w; }
        }
    }
};
struct OrderAB {
    pg8::StaticOrder base;
    __device__ __forceinline__ bool next(int i, pg8::Unit& u) const { if (!base.next(i >> 1, u)) return false; if (i & 1) { u.pm += 64; u.pn += 4; } return true; }
    __device__ __forceinline__ void a_ready(const pg8::Unit&) const {}
    __device__ __forceinline__ void done(const pg8::Unit&) const {}
};
struct EpiAB {
    static constexpr bool PERM = true, AFTER_DRAIN = false, KEEP = true, INIT = false;
    unsigned char* ws;
    __device__ __forceinline__ bool keep(const pg8::Unit& u) const { return u.pm < 64; }
    __device__ __forceinline__ void operator()(pg8::f32x4 (&acc)[2][2][4][2], const pg8::Unit& u, int wr, int wc, int fr, int fq) const {
        const bool second = u.pm >= 64; const int pm = second ? u.pm - 64 : u.pm, pn = second ? u.pn - 4 : u.pn;
        const int rowb = pm * 256 + wr * 64 + fr, colb = pn * 256 + wc * 32 + 8 * fq;
        const bf16_t* map = (const bf16_t*)(ws + WS_MA); const bf16_t* mbp = (const bf16_t*)(ws + WS_MB);
#pragma unroll
        for (int ai = 0; ai < 2; ++ai)
#pragma unroll
            for (int m = 0; m < 4; ++m) { const size_t r = rowb + 128 * ai + 16 * m;
#pragma unroll
                for (int bj = 0; bj < 2; ++bj) { const int c = colb + 128 * bj;
                    const u32x4 bw = *(const u32x4*)(mbp + r * 1024 + c);
                    float gb[8]; gb[0] = bf_lo(bw.x); gb[1] = bf_hi(bw.x); gb[2] = bf_lo(bw.y); gb[3] = bf_hi(bw.y); gb[4] = bf_lo(bw.z); gb[5] = bf_hi(bw.z); gb[6] = bf_lo(bw.w); gb[7] = bf_hi(bw.w);
#pragma unroll
                    for (int i = 0; i < 8; ++i) gb[i] = fmaxf(gb[i], 8.673617e-19f);
                    pg8::f32x4& v0 = acc[ai][bj][m][0]; pg8::f32x4& v1 = acc[ai][bj][m][1];
                    if (!second) { const u32x4 aw = *(const u32x4*)(map + r * 1024 + c);
                        v0[0] = v0[0] * bf_lo(aw.x) * __builtin_amdgcn_rcpf(gb[0]); v0[1] = v0[1] * bf_hi(aw.x) * __builtin_amdgcn_rcpf(gb[1]); v0[2] = v0[2] * bf_lo(aw.y) * __builtin_amdgcn_rcpf(gb[2]); v0[3] = v0[3] * bf_hi(aw.y) * __builtin_amdgcn_rcpf(gb[3]);
                        v1[0] = v1[0] * bf_lo(aw.z) * __builtin_amdgcn_rcpf(gb[4]); v1[1] = v1[1] * bf_hi(aw.z) * __builtin_amdgcn_rcpf(gb[5]); v1[2] = v1[2] * bf_lo(aw.w) * __builtin_amdgcn_rcpf(gb[6]); v1[3] = v1[3] * bf_hi(aw.w) * __builtin_amdgcn_rcpf(gb[7]);
                    } else {
                        u32x4 o; o.x = pk2(v0[0] * gb[0], v0[1] * gb[1]); o.y = pk2(v0[2] * gb[2], v0[3] * gb[3]); o.z = pk2(v1[0] * gb[4], v1[1] * gb[5]); o.w = pk2(v1[2] * gb[6], v1[3] * gb[7]);
                        *(u32x4*)((bf16_t*)(ws + WS_Y) + r * 1024 + c) = o; }
                }
            }
    }
};

constexpr int TROW = 144, TILEB = 64 * TROW;
__device__ __forceinline__ int kvl_of(int v, int r, int hi) { return 32 * v + 8 * (r >> 2) + 4 * hi + (r & 3); }
__device__ __forceinline__ constexpr int kvc(int v, int r) { return 32 * v + 8 * (r >> 2) + (r & 3); }
__device__ __forceinline__ void qk_tile(f32x16& p0, f32x16& p1, const LAS unsigned char* K, const bf16x8 (&qf)[4], int r32, int hi) {
    const LAS unsigned char* kb = K + r32 * TROW + hi * 16;
    f32x16 z = {0.f, 0.f, 0.f, 0.f, 0.f, 0.f, 0.f, 0.f, 0.f, 0.f, 0.f, 0.f, 0.f, 0.f, 0.f, 0.f};
    p0 = z; p1 = z;
    bf16x8 a[8];
#pragma unroll
    for (int d0 = 0; d0 < 4; ++d0) { a[2 * d0] = *(const LAS bf16x8*)(kb + d0 * 32); a[2 * d0 + 1] = *(const LAS bf16x8*)(kb + 32 * TROW + d0 * 32); }
    __builtin_amdgcn_sched_barrier(0);
#pragma unroll
    for (int d0 = 0; d0 < 4; ++d0) {
        p0 = __builtin_amdgcn_mfma_f32_32x32x16_bf16(a[2 * d0], qf[d0], p0, 0, 0, 0);
        p1 = __builtin_amdgcn_mfma_f32_32x32x16_bf16(a[2 * d0 + 1], qf[d0], p1, 0, 0, 0);
    }
}
__device__ __forceinline__ s16x4 vtr(const LAS unsigned char* p) { return __builtin_bit_cast(s16x4, __builtin_amdgcn_ds_read_tr16_b64_v4i16((LAS s16x4*)p)); }
__device__ __forceinline__ void pv_tile(f32x16 (&o)[2], const LAS unsigned char* V, const f32x16& e0, const f32x16& e1, int lane) {
    const int hi = lane >> 5;
    const LAS unsigned char* vb = V + (4 * hi + ((lane & 15) >> 2)) * TROW + (16 * ((lane >> 4) & 1) + 4 * (lane & 3)) * 2;
    s16x4 lo[4][2], hh[4][2];
#pragma unroll
    for (int ks = 0; ks < 4; ++ks)
#pragma unroll
        for (int dt = 0; dt < 2; ++dt) { lo[ks][dt] = vtr(vb + ks * 16 * TROW + dt * 64); hh[ks][dt] = vtr(vb + (ks * 16 + 8) * TROW + dt * 64); }
    u32x4 pw[4];
    pw[0].x = pk2(e0[0], e0[1]); pw[0].y = pk2(e0[2], e0[3]); pw[0].z = pk2(e0[4], e0[5]); pw[0].w = pk2(e0[6], e0[7]);
    pw[1].x = pk2(e0[8], e0[9]); pw[1].y = pk2(e0[10], e0[11]); pw[1].z = pk2(e0[12], e0[13]); pw[1].w = pk2(e0[14], e0[15]);
    pw[2].x = pk2(e1[0], e1[1]); pw[2].y = pk2(e1[2], e1[3]); pw[2].z = pk2(e1[4], e1[5]); pw[2].w = pk2(e1[6], e1[7]);
    pw[3].x = pk2(e1[8], e1[9]); pw[3].y = pk2(e1[10], e1[11]); pw[3].z = pk2(e1[12], e1[13]); pw[3].w = pk2(e1[14], e1[15]);
    __builtin_amdgcn_sched_barrier(0);
#pragma unroll
    for (int ks = 0; ks < 4; ++ks) {
        const bf16x8 pb = __builtin_bit_cast(bf16x8, pw[ks]);
#pragma unroll
        for (int dt = 0; dt < 2; ++dt) {
            const bf16x8 va = {lo[ks][dt][0], lo[ks][dt][1], lo[ks][dt][2], lo[ks][dt][3], hh[ks][dt][0], hh[ks][dt][1], hh[ks][dt][2], hh[ks][dt][3]};
            o[dt] = __builtin_amdgcn_mfma_f32_32x32x16_bf16(va, pb, o[dt], 0, 0, 0);
        }
    }
}
#define F16ZERO (f32x16){0.f, 0.f, 0.f, 0.f, 0.f, 0.f, 0.f, 0.f, 0.f, 0.f, 0.f, 0.f, 0.f, 0.f, 0.f, 0.f}

constexpr int OSTG = 272;
__device__ __forceinline__ void attn_rows_out(const f32x16 (&o)[2], LAS unsigned char* stg, const bf16_t* zbase, bf16_t* obase, int lane) {
    const int r32 = lane & 31, hi = lane >> 5;
#pragma unroll
    for (int dt = 0; dt < 2; ++dt)
#pragma unroll
        for (int c4 = 0; c4 < 4; ++c4) { f32x4 v; v.x = o[dt][4 * c4]; v.y = o[dt][4 * c4 + 1]; v.z = o[dt][4 * c4 + 2]; v.w = o[dt][4 * c4 + 3];
            *(LAS f32x4*)(stg + r32 * OSTG + (32 * dt + 8 * c4 + 4 * hi) * 4) = v; }
#pragma unroll
    for (int i = 0; i < 4; ++i) { const int row = 8 * i + (lane >> 3), ch = lane & 7;
        const f32x4 a0 = *(const LAS f32x4*)(stg + row * OSTG + ch * 32), a1 = *(const LAS f32x4*)(stg + row * OSTG + ch * 32 + 16);
        const u32x4 zw = *(const u32x4*)(zbase + (size_t)row * 512 + ch * 8);
        u32x4 w; w.x = pk2(a0.x * bf_lo(zw.x), a0.y * bf_hi(zw.x)); w.y = pk2(a0.z * bf_lo(zw.y), a0.w * bf_hi(zw.y)); w.z = pk2(a1.x * bf_lo(zw.z), a1.y * bf_hi(zw.z)); w.w = pk2(a1.z * bf_lo(zw.w), a1.w * bf_hi(zw.w));
        *(u32x4*)(obase + (size_t)row * 512 + ch * 8) = w; }
}

__device__ __forceinline__ void sb_wave_unit(unsigned char* ws, LAS unsigned char* Lw, int b, int h, int qt, int lane) {
    const int r32 = lane & 31, hi = lane >> 5;
    const int tw0 = qt * 32, t = tw0 + r32;
    const bf16_t* Qp = (const bf16_t*)(ws + WS_SBQ) + ((size_t)(b * 8 + h) * 2048) * 64;
    const bf16_t* Kp = (const bf16_t*)(ws + WS_SBK) + ((size_t)(b * 8 + h) * 2048) * 64;
    const bf16_t* Vp = (const bf16_t*)(ws + WS_SBV) + ((size_t)(b * 8 + h) * 2048) * 64;
    bf16x8 qf[4];
#pragma unroll
    for (int d0 = 0; d0 < 4; ++d0) qf[d0] = *(const bf16x8*)(Qp + (size_t)t * 64 + 16 * d0 + 8 * hi);
    f32x16 o[2]; o[0] = F16ZERO; o[1] = F16ZERO;
    float carry = 1.0f;
    const int jt0 = (tw0 + 30) >> 6;
    const int kgo = (r32 * 2 + hi) * 8;
    const int vgo = (lane >> 3) * 64 + (lane & 7) * 8, vlo = (lane >> 3) * TROW + (lane & 7) * 16;
    bf16x8 kn[8];
#pragma unroll
    for (int f = 0; f < 8; ++f) kn[f] = *(const bf16x8*)(Kp + (size_t)jt0 * 4096 + kgo + 512 * f);
    for (int jt = jt0; jt >= 0; --jt) {
        const int kb = 64 * jt;
        u32x4 vr[8];
#pragma unroll
        for (int i = 0; i < 8; ++i) vr[i] = *(const u32x4*)(Vp + (size_t)jt * 4096 + i * 512 + vgo);
        bf16x8 kc[8];
#pragma unroll
        for (int i = 0; i < 8; ++i) kc[i] = kn[i];
        if (jt > 0) {
#pragma unroll
            for (int f = 0; f < 8; ++f) kn[f] = *(const bf16x8*)(Kp + (size_t)(jt - 1) * 4096 + kgo + 512 * f);
        }
        f32x16 p0 = F16ZERO, p1 = F16ZERO;
#pragma unroll
        for (int d0 = 0; d0 < 4; ++d0) { p0 = __builtin_amdgcn_mfma_f32_32x32x16_bf16(kc[2 * d0], qf[d0], p0, 0, 0, 0); p1 = __builtin_amdgcn_mfma_f32_32x32x16_bf16(kc[2 * d0 + 1], qf[d0], p1, 0, 0, 0); }
        f32x16 k0, k1; const int lim = t - kb - 4 * hi;
        const bool full = (kb + 63 < tw0);
#pragma unroll
        for (int r = 0; r < 16; ++r) {
            { float sg = __builtin_amdgcn_rcpf(1.0f + __builtin_amdgcn_exp2f(-p0[r]));
              if (!full) sg = (kvc(0, r) < lim) ? sg : 0.f; p0[r] = sg; k0[r] = 1.0f - sg; }
            { float sg = __builtin_amdgcn_rcpf(1.0f + __builtin_amdgcn_exp2f(-p1[r]));
              if (!full) sg = (kvc(1, r) < lim) ? sg : 0.f; p1[r] = sg; k1[r] = 1.0f - sg; }
        }
        float T[8], Tp[8], U[8], R[8];
#pragma unroll
        for (int c = 0; c < 8; ++c) {
            float x0, x1, x2, x3;
            if (c < 4) { x0 = k0[4 * c]; x1 = k0[4 * c + 1]; x2 = k0[4 * c + 2]; x3 = k0[4 * c + 3]; } else { x0 = k1[4 * c - 16]; x1 = k1[4 * c - 15]; x2 = k1[4 * c - 14]; x3 = k1[4 * c - 13]; }
            const float s2 = x3, s1 = x3 * x2, s0 = s1 * x1; T[c] = s0 * x0;
            if (c < 4) { k0[4 * c] = s0; k0[4 * c + 1] = s1; k0[4 * c + 2] = s2; k0[4 * c + 3] = 1.0f; } else { k1[4 * c - 16] = s0; k1[4 * c - 15] = s1; k1[4 * c - 14] = s2; k1[4 * c - 13] = 1.0f; }
        }
#pragma unroll
        for (int c = 0; c < 8; ++c) { Tp[c] = __shfl_xor(T[c], 32); U[c] = T[c] * Tp[c]; }
        R[7] = 1.0f;
#pragma unroll
        for (int c = 6; c >= 0; --c) R[c] = R[c + 1] * U[c + 1];
#pragma unroll
        for (int c = 0; c < 8; ++c) {
            const float off = R[c] * (hi == 0 ? Tp[c] : 1.0f) * carry;
#pragma unroll
            for (int i = 0; i < 4; ++i) {
                if (c < 4) p0[4 * c + i] = p0[4 * c + i] * (k0[4 * c + i] * off);
                else p1[4 * c - 16 + i] = p1[4 * c - 16 + i] * (k1[4 * c - 16 + i] * off);
            }
        }
        carry *= R[0] * U[0];
#pragma unroll
        for (int i = 0; i < 8; ++i) *(LAS u32x4*)(Lw + i * 8 * TROW + vlo) = vr[i];
        pv_tile(o, Lw, p0, p1, lane);
        if (__all(carry < 5.421e-20f)) break;
    }
    const size_t tok0 = (size_t)b * 2048 + tw0;
    attn_rows_out(o, Lw, (const bf16_t*)(ws + WS_SBZ) + tok0 * 512 + h * 64, (bf16_t*)(ws + WS_AACT) + tok0 * 512 + h * 64, lane);
}

typedef float f32x4v __attribute__((ext_vector_type(4)));
__device__ __forceinline__ void cmp_unit(const Args& a, unsigned char* ws, LAS unsigned char* L, int l, int u, int tid, int lane, int wid) {
    const int nt = u & 7, g = (u >> 3) & 1, b = (u >> 4) & 7, kv = u >> 7;
    const int c16 = lane & 15, kq = lane >> 4;
    const bf16_t* src = (const bf16_t*)(ws + (kv ? WS_VCR : WS_KCR)) + ((size_t)(b * 2 + g) * 2048) * 64;
    const bf16_t* W1T = (const bf16_t*)(ws + WS_W1T) + (size_t)(l * 2 + kv) * 128 * 2048;
    const bf16_t* W2T = (const bf16_t*)(ws + WS_W2T) + (size_t)(l * 2 + kv) * 64 * 128;
    const float* b1v = (const float*)(ws + WS_B1) + (size_t)(l * 2 + kv) * 128;
    LAS float* red = (LAS float*)L; LAS bf16_t* hid = (LAS bf16_t*)(L + 32768); LAS float* kraw = (LAS float*)(L + 41472);
    const int j = wid & 1, kh = wid >> 1;
    f32x4v acc0 = {0.f, 0.f, 0.f, 0.f}, acc1 = {0.f, 0.f, 0.f, 0.f}, acc2 = {0.f, 0.f, 0.f, 0.f}, acc3 = {0.f, 0.f, 0.f, 0.f};
    const bf16_t* ap = src + (size_t)(16 * nt + c16 + (kh >> 1) + (kh & 1) * 1024) * 32 + 8 * kq;     const bf16_t* bp = W1T + (size_t)j * 131072 + kh * 8192 + lane * 8;
#pragma unroll 8
    for (int kk = 0; kk < 16; ++kk) {
        const bf16x8 af = *(const bf16x8*)(ap + (kk >> 1) * 4096 + (kk & 1) * 65536);
        const bf16x8 b0 = *(const bf16x8*)(bp + 512 * kk), b1 = *(const bf16x8*)(bp + 32768 + 512 * kk), b2 = *(const bf16x8*)(bp + 65536 + 512 * kk), b3 = *(const bf16x8*)(bp + 98304 + 512 * kk);
        acc0 = __builtin_amdgcn_mfma_f32_16x16x32_bf16(af, b0, acc0, 0, 0, 0);
        acc1 = __builtin_amdgcn_mfma_f32_16x16x32_bf16(af, b1, acc1, 0, 0, 0);
        acc2 = __builtin_amdgcn_mfma_f32_16x16x32_bf16(af, b2, acc2, 0, 0, 0);
        acc3 = __builtin_amdgcn_mfma_f32_16x16x32_bf16(af, b3, acc3, 0, 0, 0);
    }
    __syncthreads();
#pragma unroll
    for (int i = 0; i < 4; ++i) { LAS float* rr = red + (kh * 16 + 4 * kq + i) * 128 + 64 * j + c16; rr[0] = acc0[i]; rr[16] = acc1[i]; rr[32] = acc2[i]; rr[48] = acc3[i]; }
    __syncthreads();
    for (int e = tid; e < 16 * 128; e += 512) { const int row = e >> 7, col = e & 127; const float v = ((red[row * 128 + col] + red[(16 + row) * 128 + col]) + (red[(32 + row) * 128 + col] + red[(48 + row) * 128 + col])) + b1v[col]; hid[row * 136 + col] = (bf16_t)f2bf(siluf_(v)); }
    __syncthreads();
    if (wid < 4) {
        f32x4v o2 = {0.f, 0.f, 0.f, 0.f};
#pragma unroll
        for (int ks = 0; ks < 4; ++ks) { const bf16x8 af = *(const LAS bf16x8*)(hid + c16 * 136 + 32 * ks + 8 * kq); const bf16x8 bf = *(const bf16x8*)(W2T + (size_t)(16 * wid + c16) * 128 + 32 * ks + 8 * kq);
            o2 = __builtin_amdgcn_mfma_f32_16x16x32_bf16(af, bf, o2, 0, 0, 0); }
#pragma unroll
        for (int i = 0; i < 4; ++i) kraw[(4 * kq + i) * 65 + 16 * wid + c16] = o2[i];
    }
    __syncthreads();
    if (tid < 256) {
        const int row = tid >> 4, dl = tid & 15, n = 16 * nt + row;
        float x[4]; x[0] = kraw[row * 65 + dl]; x[1] = kraw[row * 65 + dl + 16]; x[2] = kraw[row * 65 + dl + 32]; x[3] = kraw[row * 65 + dl + 48];
        bf16_t* dst = (bf16_t*)(ws + (kv ? WS_VC : WS_KC)) + ((size_t)(b * 2 + g) * 128 + n) * 64;
        if (kv == 0) {
            float ss = x[0] * x[0] + x[1] * x[1] + x[2] * x[2] + x[3] * x[3];
            ss += __shfl_xor(ss, 1); ss += __shfl_xor(ss, 2); ss += __shfl_xor(ss, 4); ss += __shfl_xor(ss, 8);
            const float rstd = 1.0f / sqrtf(ss * (1.0f / 64.0f) + RMS_EPS); const float* gk = a.in[7] + l * 64;
            const int pos = (n < 127) ? 16 * n + 31 : 2047; const f32x2* rp = (const f32x2*)(ws + WS_ROPE) + (size_t)pos * 32;
#pragma unroll
            for (int q = 0; q < 2; ++q) { const int i = dl + 16 * q; const float x1 = x[q] * rstd * gk[i], x2 = x[2 + q] * rstd * gk[i + 32]; const f32x2 cs = rp[i];
                x[q] = x1 * cs.x - x2 * cs.y; x[2 + q] = x2 * cs.x + x1 * cs.y; }
        }
        if (n == 127) { x[0] = 0.f; x[1] = 0.f; x[2] = 0.f; x[3] = 0.f; }
        dst[dl] = (bf16_t)f2bf(x[0]); dst[dl + 16] = (bf16_t)f2bf(x[1]); dst[dl + 32] = (bf16_t)f2bf(x[2]); dst[dl + 48] = (bf16_t)f2bf(x[3]);
    }
}

__device__ __forceinline__ void softmax_step(f32x16& p0, f32x16& p1, float& m, float& lsum, f32x16 (&o)[2], int kb, int t, int mode, bool sel, int hi) {
    if (mode != 0 || !sel) {
        int lo = -1000000, hi_ = 1000000;
        if (mode == 1) hi_ = t - kb - 4 * hi; else if (mode == 2) lo = t - 255 - kb - 4 * hi;
        if (!sel) hi_ = -2000000;
#pragma unroll
        for (int r = 0; r < 16; ++r) {
            p0[r] = (kvc(0, r) >= lo && kvc(0, r) <= hi_) ? p0[r] : NEGF; p1[r] = (kvc(1, r) >= lo && kvc(1, r) <= hi_) ? p1[r] : NEGF;
        }
    }
    float rm = fmaxf(p0[0], p1[0]);
#pragma unroll
    for (int r = 1; r < 16; ++r) rm = fmaxf(rm, fmaxf(p0[r], p1[r]));
    rm = fmaxf(rm, __shfl_xor(rm, 32));
    const float mn = fmaxf(m, rm), alpha = __builtin_amdgcn_exp2f(m - mn);
    float ls = 0.f;
#pragma unroll
    for (int r = 0; r < 16; ++r) { p0[r] = __builtin_amdgcn_exp2f(p0[r] - mn); p1[r] = __builtin_amdgcn_exp2f(p1[r] - mn); ls += p0[r] + p1[r]; }
    lsum = lsum * alpha + ls; m = mn;
#pragma unroll
    for (int r = 0; r < 16; ++r) { o[0][r] *= alpha; o[1][r] *= alpha; }
}

__device__ __forceinline__ void qk_tile_c(f32x16& p0, f32x16& p1, const LAS unsigned char* K, const bf16x8 (&qf)[4], int r32, int hi, const f32x16& c) {
    const LAS unsigned char* kb = K + r32 * TROW + hi * 16;
    p0 = c; p1 = c;
    bf16x8 a[8];
#pragma unroll
    for (int d0 = 0; d0 < 4; ++d0) { a[2 * d0] = *(const LAS bf16x8*)(kb + d0 * 32); a[2 * d0 + 1] = *(const LAS bf16x8*)(kb + 32 * TROW + d0 * 32); }
    __builtin_amdgcn_sched_barrier(0);
#pragma unroll
    for (int d0 = 0; d0 < 4; ++d0) {
        p0 = __builtin_amdgcn_mfma_f32_32x32x16_bf16(a[2 * d0], qf[d0], p0, 0, 0, 0);
        p1 = __builtin_amdgcn_mfma_f32_32x32x16_bf16(a[2 * d0 + 1], qf[d0], p1, 0, 0, 0);
    }
}
__device__ __forceinline__ void softmax_step_lazy(f32x16& p0, f32x16& p1, float& mref, float& lsum, f32x16 (&o)[2], int kb, int t, int mode, int hi, bool first) {
    if (mode != 0) {
        int lo = -1000000, hi_ = 1000000;
        if (mode == 1) hi_ = t - kb - 4 * hi; else if (mode == 2) lo = t - 255 - kb - 4 * hi;
#pragma unroll
        for (int r = 0; r < 16; ++r) {
            p0[r] = (kvc(0, r) >= lo && kvc(0, r) <= hi_) ? p0[r] : NEGF; p1[r] = (kvc(1, r) >= lo && kvc(1, r) <= hi_) ? p1[r] : NEGF;
        }
    }
    float rm = fmaxf(p0[0], p1[0]);
#pragma unroll
    for (int r = 1; r < 16; ++r) rm = fmaxf(rm, fmaxf(p0[r], p1[r]));
    rm = fmaxf(rm, __shfl_xor(rm, 32));
    if (first || __any(rm > 8.0f)) {
        const float dl = first ? rm : fmaxf(rm, 0.f), alpha = __builtin_amdgcn_exp2f(-dl);
        mref += dl; lsum *= alpha;
#pragma unroll
        for (int r = 0; r < 16; ++r) { p0[r] -= dl; p1[r] -= dl; o[0][r] *= alpha; o[1][r] *= alpha; }
    }
    float ls = 0.f;
#pragma unroll
    for (int r = 0; r < 16; ++r) { p0[r] = __builtin_amdgcn_exp2f(p0[r]); p1[r] = __builtin_amdgcn_exp2f(p1[r]); ls += p0[r] + p1[r]; }
    lsum += ls;
}

__device__ __forceinline__ void nsa_unit(unsigned char* ws, LAS unsigned char* L, int b, int g, int cur, int tid, int lane, int wid) {
    const int r32 = lane & 31, hi = lane >> 5, hh = wid >> 1, qh = wid & 1, h = 4 * g + hh;
    const int ql = 32 * qh + r32, t = 64 * cur + ql; const size_t tok = (size_t)b * 2048 + t;
    const bf16_t* Qp = (const bf16_t*)(ws + WS_NQ) + ((size_t)(b * 8 + h) * 2048 + t) * 64;
    bf16x8 qf[4];
#pragma unroll
    for (int d0 = 0; d0 < 4; ++d0) qf[d0] = *(const bf16x8*)(Qp + 16 * d0 + 8 * hi);
    const bf16_t* KCp = (const bf16_t*)(ws + WS_KC) + (size_t)(b * 2 + g) * 128 * 64; const bf16_t* VCp = (const bf16_t*)(ws + WS_VC) + (size_t)(b * 2 + g) * 128 * 64;
    const size_t kvo = (size_t)(b * 2 + g) * 2048 * 64;
    const bf16_t* KSp = (const bf16_t*)(ws + WS_KS) + kvo; const bf16_t* VSp = (const bf16_t*)(ws + WS_VS) + kvo;
    const bf16_t* KWp = (const bf16_t*)(ws + WS_KW) + kvo; const bf16_t* VWp = (const bf16_t*)(ws + WS_VW) + kvo;
    LAS float* IMP = (LAS float*)(L + 4 * TILEB); LAS unsigned* SEL = (LAS unsigned*)(L + 4 * TILEB + 4 * 64 * 33 * 4);
    const int goff = (tid >> 3) * 64 + (tid & 7) * 8, loff = (tid >> 3) * TROW + (tid & 7) * 16;
    const float* ngp = (const float*)(ws + WS_NG) + tok * 24 + h;
    f32x16 res[2];
    u32x4 rk = *(const u32x4*)(KSp + (size_t)cur * 4096 + goff), rv = *(const u32x4*)(VSp + (size_t)cur * 4096 + goff);
    {
        const u32x4 rk0 = *(const u32x4*)(KCp + goff), rk1 = *(const u32x4*)(KCp + 4096 + goff), rv0 = *(const u32x4*)(VCp + goff), rv1 = *(const u32x4*)(VCp + 4096 + goff);
        __syncthreads();
        *(LAS u32x4*)(L + loff) = rk0; *(LAS u32x4*)(L + TILEB + loff) = rk1; *(LAS u32x4*)(L + 2 * TILEB + loff) = rv0; *(LAS u32x4*)(L + 3 * TILEB + loff) = rv1;
        __syncthreads();
        f32x16 p0, p1, p2, p3; qk_tile(p0, p1, L, qf, r32, hi); qk_tile(p2, p3, L + TILEB, qf, r32, hi);
        float mx = NEGF;
        const int thr = ((t - 31) >> 4) - 4 * hi;
#pragma unroll
        for (int r = 0; r < 16; ++r) {
            p0[r] = (kvc(0, r) <= thr) ? p0[r] : NEGF; p1[r] = (kvc(1, r) <= thr) ? p1[r] : NEGF; p2[r] = (kvc(2, r) <= thr) ? p2[r] : NEGF; p3[r] = (kvc(3, r) <= thr) ? p3[r] : NEGF;
            mx = fmaxf(fmaxf(mx, fmaxf(p0[r], p1[r])), fmaxf(p2[r], p3[r]));
        }
        mx = fmaxf(mx, __shfl_xor(mx, 32));
        float ls = 0.f;
#pragma unroll
        for (int r = 0; r < 16; ++r) {
            p0[r] = (p0[r] > -1e29f) ? __builtin_amdgcn_exp2f(p0[r] - mx) : 0.f; p1[r] = (p1[r] > -1e29f) ? __builtin_amdgcn_exp2f(p1[r] - mx) : 0.f;
            p2[r] = (p2[r] > -1e29f) ? __builtin_amdgcn_exp2f(p2[r] - mx) : 0.f; p3[r] = (p3[r] > -1e29f) ? __builtin_amdgcn_exp2f(p3[r] - mx) : 0.f;
            ls += (p0[r] + p1[r]) + (p2[r] + p3[r]);
        }
        ls += __shfl_xor(ls, 32);
        const float inv = ls > 0.f ? 1.0f / ls : 0.f;
#pragma unroll
        for (int r = 0; r < 16; ++r) { p0[r] *= inv; p1[r] *= inv; p2[r] *= inv; p3[r] *= inv; }
        float gs[16], tl[16], tlp[16];
#pragma unroll
        for (int c = 0; c < 4; ++c) {
            gs[c] = (p0[4 * c] + p0[4 * c + 1]) + (p0[4 * c + 2] + p0[4 * c + 3]); tl[c] = p0[4 * c + 3];
            gs[4 + c] = (p1[4 * c] + p1[4 * c + 1]) + (p1[4 * c + 2] + p1[4 * c + 3]); tl[4 + c] = p1[4 * c + 3];
            gs[8 + c] = (p2[4 * c] + p2[4 * c + 1]) + (p2[4 * c + 2] + p2[4 * c + 3]); tl[8 + c] = p2[4 * c + 3];
            gs[12 + c] = (p3[4 * c] + p3[4 * c + 1]) + (p3[4 * c + 2] + p3[4 * c + 3]); tl[12 + c] = p3[4 * c + 3];
        }
#pragma unroll
        for (int c = 0; c < 16; ++c) tlp[c] = __shfl_xor(tl[c], 32);
        LAS float* impr = IMP + (hh * 64 + ql) * 33;
        if (cur > 7)
#pragma unroll
        for (int c = 0; c < 16; ++c) {
            const float prev0 = (c > 0) ? tlp[c - 1] : 0.f;
            impr[2 * c + hi] = gs[c] + (hi ? tlp[c] : prev0);
        }
        f32x16 o[2]; o[0] = F16ZERO; o[1] = F16ZERO;
        pv_tile(o, L + 2 * TILEB, p0, p1, lane); pv_tile(o, L + 3 * TILEB, p2, p3, lane);
        const float g0 = ngp[0];
#pragma unroll
        for (int r = 0; r < 16; ++r) { res[0][r] = o[0][r] * g0; res[1][r] = o[1][r] * g0; }
        if (cur > 7) {
        __syncthreads();
        if (wid == 0) {
            float v[32];
#pragma unroll
            for (int j = 0; j < 32; ++j) v[j] = ((IMP[(0 * 64 + lane) * 33 + j] + IMP[(1 * 64 + lane) * 33 + j]) + IMP[(2 * 64 + lane) * 33 + j]) + IMP[(3 * 64 + lane) * 33 + j];
            unsigned mask;
            if (cur <= 7) mask = (2u << cur) - 1u;
            else {
                mask = 1u | (1u << (cur - 1)) | (1u << cur);
#pragma unroll
                for (int j = 1; j < 30; ++j) if (j > cur - 2) v[j] = -1.0f;
                for (int pick = 0; pick < 5; ++pick) {
                    float best = -0.5f; int bi = 1;
#pragma unroll
                    for (int j = 1; j < 30; ++j) { if (v[j] > best) { best = v[j]; bi = j; } }
                    mask |= 1u << bi;
#pragma unroll
                    for (int j = 1; j < 30; ++j) if (j == bi) v[j] = -1.0f;
                }
            }
            SEL[lane] = mask;
        }
        }
        __syncthreads();
    }
    const unsigned selm = (cur > 7) ? SEL[ql] : ((2u << cur) - 1u);
    const int n_slc = cur + 1, n_win = (cur + 1 < 5) ? cur + 1 : 5, total = n_slc + n_win;
    *(LAS u32x4*)(L + loff) = rk; *(LAS u32x4*)(L + 2 * TILEB + loff) = rv;
    __syncthreads();
    float mref = 0.f, lsum = 0.f; bool first = true; f32x16 o[2]; o[0] = F16ZERO; o[1] = F16ZERO;
    int cb = 0;
    for (int i = 0; i < total; ++i) {
        if (i + 1 < total) {
            const int i2 = i + 1; const bool w2 = i2 >= n_slc; const int j2 = w2 ? cur - (i2 - n_slc) : cur - i2;
            rk = *(const u32x4*)((w2 ? KWp : KSp) + (size_t)j2 * 4096 + goff); rv = *(const u32x4*)((w2 ? VWp : VSp) + (size_t)j2 * 4096 + goff);
        }
        const bool isw = i >= n_slc; const int j = isw ? cur - (i - n_slc) : cur - i;
        int mode = 0; bool sel = true;
        if (j == cur) mode = 1; else if (isw && j == cur - 4) mode = 2;
        if (!isw) sel = (selm >> j) & 1u;
        {
            const float cv = sel ? -mref : NEGF;
            f32x16 cc;
#pragma unroll
            for (int r = 0; r < 16; ++r) cc[r] = cv;
            f32x16 p0, p1; qk_tile_c(p0, p1, L + cb * TILEB, qf, r32, hi, cc);
            softmax_step_lazy(p0, p1, mref, lsum, o, 64 * j, t, mode, hi, first); first = false;
            pv_tile(o, L + (2 + cb) * TILEB, p0, p1, lane);
        }
        if (i == n_slc - 1 || i == total - 1) {
            const float lt = lsum + __shfl_xor(lsum, 32); const float gg = ngp[isw ? 16 : 8] / lt;
#pragma unroll
            for (int r = 0; r < 16; ++r) { res[0][r] += o[0][r] * gg; res[1][r] += o[1][r] * gg; }
            mref = 0.f; first = true; lsum = 0.f; o[0] = F16ZERO; o[1] = F16ZERO;
        }
        if (i + 1 < total) { *(LAS u32x4*)(L + (cb ^ 1) * TILEB + loff) = rk; *(LAS u32x4*)(L + (2 + (cb ^ 1)) * TILEB + loff) = rv; }
        __syncthreads();
        cb ^= 1;
    }
    const size_t tok0 = (size_t)b * 2048 + 64 * cur + 32 * qh;
    attn_rows_out(res, L + wid * (32 * OSTG), (const bf16_t*)(ws + WS_NZ) + tok0 * 512 + h * 64, (bf16_t*)(ws + WS_BACT) + tok0 * 512 + h * 64, lane);
}

#define XB_TMO      128
#define XB_XCNT(j)  (256  + 64 * (j))
#define XB_XSUB(j)  (1280 + 64 * (j))
#define XB_XGEN(j)  (2304 + 64 * (j))
#define XB_TOP      3328
#define XB_TOPGEN   3392
#define XCD_BAR_WORDS 3456
#define XB_SPIN_CAP (1u << 18)

__device__ __forceinline__ unsigned xb_ld(unsigned* p)              { return __hip_atomic_load(p, __ATOMIC_RELAXED, __HIP_MEMORY_SCOPE_AGENT); }
__device__ __forceinline__ unsigned xb_add(unsigned* p, unsigned v) { return __hip_atomic_fetch_add(p, v, __ATOMIC_RELAXED, __HIP_MEMORY_SCOPE_AGENT); }
__device__ __forceinline__ unsigned xb_xcc_id() { return (unsigned)__builtin_amdgcn_s_getreg((3 << 11) | 20) & 0xFu; }
#define XB_SPIN(cond, bar) do { unsigned _sp = 0; while (cond) { __builtin_amdgcn_s_sleep(1); \
    if ((++_sp & 255u) == 0u) { if (xb_ld(&(bar)[XB_TMO])) break; if (_sp > XB_SPIN_CAP) { atomicAdd(&(bar)[XB_TMO], 1u); break; } } } } while (0)

struct XcdBarrier {
    unsigned* bar; unsigned x;
    volatile LAS unsigned* st;
};

__device__ __forceinline__ XcdBarrier xcd_barrier_post(unsigned* bar, volatile LAS unsigned* st) {
    XcdBarrier b; b.bar = bar; b.x = xb_xcc_id(); b.st = st;
    if (threadIdx.x == 0) (void)xb_add(&bar[XB_XCNT(b.x)], 1u);
    return b;
}
__device__ __forceinline__ void xcd_barrier_complete(unsigned* bar, unsigned x, unsigned& nloc, unsigned& nx) {
    const unsigned G = gridDim.x * gridDim.y * gridDim.z;
    unsigned sum, cnt, mine, sp = 0u;
    for (;;) {
        sum = 0u; cnt = 0u; mine = 0u;
#pragma unroll
        for (unsigned j = 0; j < 16; ++j) { const unsigned c = xb_ld(&bar[XB_XCNT(j)]); sum += c; cnt += (c > 0u) ? 1u : 0u; mine = (j == x) ? c : mine; }
        if (sum == G) break;
        __builtin_amdgcn_s_sleep(1);
        if ((++sp & 255u) == 0u) { if (xb_ld(&bar[XB_TMO])) break; if (sp > XB_SPIN_CAP) { atomicAdd(&bar[XB_TMO], 1u); break; } }
    }
    nloc = mine > 0u ? mine : 1u; nx = cnt > 0u ? cnt : 1u;
}

__device__ __forceinline__ void xcd_barrier(const XcdBarrier& b) {
    asm volatile("s_waitcnt vmcnt(0)" ::: "memory");
    __syncthreads();
    if (threadIdx.x == 0) {
        unsigned* bar = b.bar;
        __builtin_amdgcn_s_waitcnt(0);
        unsigned nloc = b.st[0], nx = b.st[1];
        if (nloc == 0u) { xcd_barrier_complete(bar, b.x, nloc, nx); b.st[0] = nloc; b.st[1] = nx; }
        const unsigned old = xb_add(&bar[XB_XSUB(b.x)], 1u);
        const unsigned gen = old / nloc;
        if (old + 1u == (gen + 1u) * nloc) {
            __builtin_amdgcn_fence(__ATOMIC_RELEASE, "agent");
            asm volatile("s_waitcnt vmcnt(0)" ::: "memory");
            const unsigned og = xb_add(&bar[XB_TOP], 1u);
            const unsigned tg = og / nx;
            if (og + 1u == (tg + 1u) * nx) xb_add(&bar[XB_TOPGEN], 1u);
            else XB_SPIN(xb_ld(&bar[XB_TOPGEN]) == tg, bar);
            __builtin_amdgcn_fence(__ATOMIC_ACQUIRE, "agent");
            xb_add(&bar[XB_XGEN(b.x)], 1u);
            asm volatile("s_waitcnt vmcnt(0)" ::: "memory");
        } else {
            XB_SPIN(xb_ld(&bar[XB_XGEN(b.x)]) == gen, bar);
            __builtin_amdgcn_fence(__ATOMIC_ACQUIRE, "agent");
            asm volatile("s_waitcnt vmcnt(0)" ::: "memory");
        }
    }
    __syncthreads();
}

__global__ void __launch_bounds__(512, 2) mega_fwd(Args a) {
    extern __shared__ __attribute__((aligned(16))) unsigned char lds_raw[];
    LAS unsigned char* L = (LAS unsigned char*)lds_raw;
    cg::grid_group grid = cg::this_grid();
    int ph = a.ph_lo;
    const int wid0 = __builtin_amdgcn_readfirstlane(threadIdx.x >> 6);
    volatile LAS unsigned* bst = (volatile LAS unsigned*)(L + 131072 + 64);
    if (threadIdx.x < 16) bst[threadIdx.x] = 0u;
    __syncthreads();
    const XcdBarrier xbar = xcd_barrier_post((unsigned*)(a.ws + WS_BAR), bst);
#define SEAM() do { if (a.use_cg) grid.sync(); else xcd_barrier(xbar); } while (0)
    if (ph == 0) {
        const int tid = threadIdx.x, lane = tid & 63, wid = __builtin_amdgcn_readfirstlane(tid >> 6);
        phase0(a, a.ws, L, tid, lane, wid);
        ++ph;
        if (ph < a.ph_hi) SEAM();
    }
    int rep_done = 0;
    for (; ph < a.ph_hi; ) {
        __attribute__((address_space(1))) unsigned char* ws_g = (__attribute__((address_space(1))) unsigned char*)a.ws; asm volatile("" : "+s"(ws_g));
        unsigned char* ws = (unsigned char*)ws_g;
        int lane_l = __builtin_amdgcn_mbcnt_hi(~0u, __builtin_amdgcn_mbcnt_lo(~0u, 0u)), wid_l = wid0; asm volatile("" : "+v"(lane_l), "+s"(wid_l));
        const int lane = lane_l, wid = wid_l, tid = wid * 64 + lane;
        int bid = blockIdx.x, gdim = gridDim.x; asm volatile("" : "+s"(bid), "+s"(gdim));
        if ((ph - 1) % 5 == 0 && ph > 1 && gdim == 256) { ++ph; continue; }
        {
            const int l = (ph - 1) / 5, k = (ph - 1) % 5;
            const float* xin = (l == 0) ? a.in[0] : a.out;
            if (k == 0) {
                if (l == 0 && bid == gdim - 1) {
                    for (int e = tid; e < 1024; e += 512) { const float* pp = (const float*)(ws + WS_B1P) + (size_t)(e >> 7) * 16 * 128 + (e & 127); float sacc = 0.f;
#pragma unroll
                        for (int q = 0; q < 16; ++q) sacc += pp[q * 128];
                        ((float*)(ws + WS_B1))[e] = sacc; }
                }
                phase1(a, ws, xin, l, lane, bid * 8 + wid, gdim * 8, MTOK);
            }
            else if (k == 1) {
                pg8::Gemm gm{(const pg8::bf16_t*)(ws + WS_H), (const pg8::bf16_t*)(ws + WS_WINT) + (size_t)l * NINP * 1024, MTOK, NINP, 1024};
                pg8::StaticOrder S; S.init(MTOK, NINP, gdim, bid);
                EpiIn E{ws, a.in[6] + l * 64, a.in[8] + l * 64, a.in[9] + l * 64};
                pg8::gemm_phase<EpiIn, pg8::StaticOrder, true, true>((PG8_LAS unsigned char*)L, gm, S, E, tid);
            } else if (k == 2) {
                for (int u = bid; u < 256; u += gdim) {
                    cmp_unit(a, ws, L, l, u, tid, lane, wid);
                    asm volatile("s_waitcnt vmcnt(0)" ::: "memory");
                    __syncthreads();
                    if (tid == 0) { __builtin_amdgcn_fence(__ATOMIC_RELEASE, "agent"); asm volatile("s_waitcnt vmcnt(0)" ::: "memory");
                        __hip_atomic_fetch_add((unsigned*)(ws + WS_BAR) + 3584 + 64 * l, 1u, __ATOMIC_RELAXED, __HIP_MEMORY_SCOPE_AGENT); }
                }
                __syncthreads();
                for (int c = bid; c < 256; c += gdim)
                    for (int i = 0; i < 2; ++i) { const int bh = c >> 2, qt = 16 * (c & 3) + 2 * wid + i; sb_wave_unit(ws, L + wid * TILEB, bh >> 3, bh & 7, qt, lane); }
                if (tid == 0) {
                    unsigned* cnt = (unsigned*)(ws + WS_BAR) + 3584 + 64 * l; unsigned sp = 0;
                    while (__hip_atomic_load(cnt, __ATOMIC_RELAXED, __HIP_MEMORY_SCOPE_AGENT) < 256u) { __builtin_amdgcn_s_sleep(2); if (++sp > (1u << 22)) break; }
                    __builtin_amdgcn_fence(__ATOMIC_ACQUIRE, "agent");
                    asm volatile("s_waitcnt vmcnt(0)" ::: "memory");
                }
                __syncthreads();
                for (int c = bid; c < 256; c += gdim) {
                    const int bg = c & 15, s = c >> 4;
                    nsa_unit(ws, L, bg >> 1, bg & 1, 31 - s, tid, lane, wid);
                    nsa_unit(ws, L, bg >> 1, bg & 1, s, tid, lane, wid);
                }
            } else if (k == 3) {
                OrderAB S; S.base.init(MTOK, 1024, gdim, bid);
                pg8::Gemm gm{(const pg8::bf16_t*)(ws + WS_AACT), (const pg8::bf16_t*)(ws + WS_WABT) + (size_t)l * 2048 * 512, 2 * MTOK, 2048, 512};
                EpiAB E{ws}; pg8::gemm_phase<EpiAB, OrderAB, true, true>((PG8_LAS unsigned char*)L, gm, S, E, tid);
            } else {
                pg8::StaticOrder S; S.init(MTOK, 1024, gdim, bid);
                pg8::Gemm gm{(const pg8::bf16_t*)(ws + WS_Y), (const pg8::bf16_t*)(ws + WS_WOT) + (size_t)l * 1024 * 1024, MTOK, 1024, 1024};
                const int ln = (l < 3) ? l + 1 : l;
                EpiOutNorm E{ws, xin, a.out, (const float*)(ws + WS_MOD) + (size_t)l * 8 * 3072 + 2048, a.in[4] + ln * 1024, (const float*)(ws + WS_MOD) + (size_t)ln * 8 * 3072,
                             (unsigned*)(ws + WS_BAR) + 3840 + 64 * l, (l < 3 && gdim == 256) ? 1 : 0};
                pg8::gemm_phase<EpiOutNorm, pg8::StaticOrder, false, true>((PG8_LAS unsigned char*)L, gm, S, E, tid);
            }
        }
        if (PROBE_N > 1 && (ph - 1) % 5 == PROBE_K && rep_done + 1 < PROBE_N) { ++rep_done; SEAM(); continue; }
        rep_done = 0;
        if (ph + 1 < a.ph_hi) { SEAM(); if (PROBE_K == 99 && PROBE_N > 1) SEAM(); }
        ++ph;
    }
}

#ifndef MK_PER_PHASE
#define MK_PER_PHASE 0
#endif
extern "C" void kernel_launch(void* const* d_in, const int* in_sizes, int n_in, void* d_out, int out_size, void* d_ws, size_t ws_size, hipStream_t stream) {
    static int grid = 0;
    if (grid == 0) {
        if (n_in != 19 || out_size != MTOK * DM || ws_size < WS_END) { fprintf(stderr, "kernel_launch: unexpected shapes (n_in %d out %d ws %zu need %zu)\n", n_in, out_size, ws_size, (size_t)WS_END); grid = -1; return; }
        int dev = 0, cus = 0, per_cu = 0;
        hipGetDevice(&dev); hipDeviceGetAttribute(&cus, hipDeviceAttributeMultiprocessorCount, dev);
        if (hipFuncSetAttribute((const void*)mega_fwd, hipFuncAttributeMaxDynamicSharedMemorySize, LDS_BYTES) != hipSuccess) { fprintf(stderr, "kernel_launch: hipFuncSetAttribute failed\n"); grid = -1; return; }
        if (hipOccupancyMaxActiveBlocksPerMultiprocessor(&per_cu, (const void*)mega_fwd, 512, LDS_BYTES) != hipSuccess || per_cu < 1) { fprintf(stderr, "kernel_launch: occupancy query says %d\n", per_cu); per_cu = 1; }
        (void)hipGetLastError();
        grid = cus * 1;
        if (grid > 256) grid = 256;
    }
    if (grid < 0) return;
    Args a{};
    for (int i = 0; i < 19; ++i) a.in[i] = (const float*)d_in[i];
    a.out = (float*)d_out; a.ws = (unsigned char*)d_ws; a.use_cg = 0; a.pad = 0;
    if (hipMemsetAsync((unsigned char*)d_ws + WS_BAR, 0, 16384, stream) != hipSuccess) { fprintf(stderr, "kernel_launch: memset failed\n"); return; }
#if MK_PER_PHASE
    for (int ph = 0; ph < 21; ++ph) { a.ph_lo = ph; a.ph_hi = ph + 1; hipLaunchKernelGGL(mega_fwd, dim3(grid), dim3(512), LDS_BYTES, stream, a); }
#else
    a.ph_lo = 0; a.ph_hi = 21;
    void* args[] = {&a};
    hipError_t e = hipLaunchCooperativeKernel((const void*)mega_fwd, dim3(grid), dim3(512), args, LDS_BYTES, stream);
    if (e != hipSuccess) fprintf(stderr, "cooperative launch failed: %s (grid %d)\n", hipGetErrorString(e), grid);
#endif
}
```
